# Optimizing an MI355X kernel written in HIP

```python
import jax, jax.numpy as jnp
from jax import lax
import numpy as np


D_MODEL = 1024
BATCH = 1
SEQ = 16384
DEPTH = 4

N_EVEN = (DEPTH + 1) // 2
N_ODD = DEPTH // 2
N_VRES = max(N_EVEN - 1, 0)

D_MIX = D_MODEL
HEAD_A = 64
D_A = D_MIX // 2
H_A = D_A // HEAD_A
LORA_W = 64
LORA_A = 64
LORA_V = 32
LORA_G = 128
GN_EPS = 64e-5
SPLIT_A = (D_A, 2 * D_A, 3 * D_A, 3 * D_A + LORA_W, 3 * D_A + LORA_W + LORA_A)
D_IN_A = 3 * D_A + LORA_W + LORA_A + LORA_G
D_B = D_MIX - D_A
CONV_B = 3
D_IN_EVEN = D_IN_A + 3 * D_B
D_C = D_MIX // 2
H_C = 8
BLK_C = D_C // H_C
CONV_C = 4
LRU_C = 8.0
D_D = D_MIX - D_C
POOL_WINDOWS = (2, 4, 8, 16)
N_POOL = len(POOL_WINDOWS)
G_D = D_D // N_POOL
D_IN_ODD = 2 * D_C + D_D
D_FF = 2816
RMS_EPS = 1e-6

kernel_name = 'hybrid_rwkv7_shortconv_rglru_pool_macaron'


def rmsnorm(x, g):
    xf = x.astype(jnp.float32)
    y = xf * lax.rsqrt(jnp.mean(xf * xf, axis=-1, keepdims=True) + RMS_EPS)
    return (y * g.astype(jnp.float32)).astype(x.dtype)


def swiglu(h, w_gate, w_up, w_down):
    return (jax.nn.silu(h @ w_gate) * (h @ w_up)) @ w_down


def token_shift(z):
    return jnp.pad(z[:, :-1], ((0, 0), (1, 0), (0, 0)))


def causal_dwconv(z, w):
    K, C = w.shape
    return lax.conv_general_dilated(
        z, w[:, None, :].astype(z.dtype), window_strides=(1,), padding=[(K - 1, 0)],
        dimension_numbers=('NWC', 'WIO', 'NWC'), feature_group_count=C)


def rwkv7_scan(r, decay, k, v, kk, a):
    B, T, H, N = r.shape

    def step(S, inp):
        r_t, w_t, k_t, v_t, kk_t, a_t = inp
        sk = jnp.einsum('bhvk,bhk->bhv', S, kk_t)
        S = (S * w_t[:, :, None, :]
             - sk[..., None] * (kk_t * a_t)[:, :, None, :]
             + v_t[..., None] * k_t[:, :, None, :])
        return S, jnp.einsum('bhvk,bhk->bhv', S, r_t)

    xs = tuple(jnp.moveaxis(z, 1, 0) for z in (r, decay, k, v, kk, a))
    S0 = jnp.zeros((B, H, N, N), jnp.float32)
    _, y = lax.scan(step, S0, xs)
    return jnp.moveaxis(y, 0, 1)


def rwkv7_time_mix(p, mu, w0, w_up, a0, a_up, g_up, k_k, k_a, r_k, ln_w, ln_b, v_first, v_res):
    B, T, _ = p.shape
    p = p.astype(jnp.float32)
    p = p + (token_shift(p) - p) * mu
    r, k, v, xw, xa, xg = jnp.split(p, SPLIT_A, axis=-1)
    w = -jax.nn.softplus(-(w0 + jnp.tanh(xw) @ w_up)) - 0.5
    decay = jnp.exp(-jnp.exp(w))
    a = jax.nn.sigmoid(a0 + xa @ a_up)
    g = jax.nn.sigmoid(xg) @ g_up
    if v_res is not None:
        v0, v_dn, v_up = v_res
        v = v + (v_first - v) * jax.nn.sigmoid(v0 + (v @ v_dn) @ v_up)
    heads = lambda z: z.reshape(B, T, H_A, HEAD_A)
    kk = heads(k * k_k)
    kk = kk * lax.rsqrt(jnp.maximum(jnp.sum(kk * kk, axis=-1, keepdims=True), 1e-24))
    k = k * (1.0 + (a - 1.0) * k_a)
    rh, kh, vh = heads(r), heads(k), heads(v)
    y = rwkv7_scan(rh, heads(decay), kh, vh, kk, heads(a))
    mean = jnp.mean(y, axis=-1, keepdims=True)
    var = jnp.mean(jnp.square(y - mean), axis=-1, keepdims=True)
    y = (y - mean) * lax.rsqrt(var + GN_EPS) * ln_w.reshape(H_A, HEAD_A) + ln_b.reshape(H_A, HEAD_A)
    y = y + jnp.sum(rh * kh * r_k, axis=-1, keepdims=True) * vh
    return y.reshape(B, T, D_A) * g, v


def short_conv_mix(p, conv_w):
    b, c, h = jnp.split(p.astype(jnp.float32), 3, axis=-1)
    return b * causal_dwconv(c * h, conv_w)


def rglru_mix(p, conv_w, conv_b, w_a, b_a, w_x, b_x, lam):
    B, T, _ = p.shape
    p = p.astype(jnp.float32)
    gate, u = p[..., :D_C], p[..., D_C:]
    u = causal_dwconv(u, conv_w) + conv_b
    ub = u.reshape(B, T, H_C, BLK_C)
    r = jax.nn.sigmoid(jnp.einsum('bthi,hij->bthj', ub, w_a) + b_a)
    i = jax.nn.sigmoid(jnp.einsum('bthi,hij->bthj', ub, w_x) + b_x)
    log_a = -LRU_C * r * jax.nn.softplus(-lam)
    a = jnp.exp(log_a)
    mult = jnp.sqrt(-jnp.expm1(2.0 * log_a))
    mult = jnp.where((jnp.arange(T) == 0)[None, :, None, None], 1.0, mult)
    bx = mult * i * ub

    def combine(c1, c2):
        a1, b1 = c1
        a2, b2 = c2
        return a1 * a2, a2 * b1 + b2

    _, h = lax.associative_scan(combine, (a, bx), axis=1)
    return jax.nn.gelu(gate) * h.reshape(B, T, D_C)


def multiscale_pool_mix(p, w_grp, scale):
    B, T, _ = p.shape
    pg = p.astype(jnp.float32).reshape(B, T, N_POOL, G_D)
    cs = jnp.cumsum(pg, axis=1)
    n_avail = jnp.arange(1, T + 1, dtype=jnp.float32)
    pooled = []
    for gi, win in enumerate(POOL_WINDOWS):
        c = cs[:, :, gi]
        c_lag = jnp.pad(c, ((0, 0), (win, 0), (0, 0)))[:, :T]
        pooled.append((c - c_lag) / jnp.minimum(n_avail, float(win))[None, :, None])
    d = jnp.stack(pooled, axis=2) - pg
    y = jnp.einsum('btgi,gij->btgj', d, w_grp) * scale.reshape(N_POOL, G_D)
    return y.reshape(B, T, D_D)


def setup_inputs(seed: int = 0) -> dict:
    key = jax.random.key(seed)
    ks = iter(jax.random.split(key, 40))
    nrm = lambda shape, s: s * jax.random.normal(next(ks), shape, jnp.float32)
    unif = lambda shape, lo, hi: jax.random.uniform(next(ks), shape, jnp.float32, lo, hi)
    lam_s = unif((N_ODD, H_C, BLK_C), 0.9, 0.999) ** (1.0 / LRU_C)
    return {
        'x': nrm((BATCH, SEQ, D_MODEL), 1.0),
        'norm_g': 1.0 + nrm((DEPTH, 3, D_MODEL), 0.02),
        'ffn_wg': nrm((DEPTH, 2, D_MODEL, D_FF), D_MODEL ** -0.5),
        'ffn_wu': nrm((DEPTH, 2, D_MODEL, D_FF), D_MODEL ** -0.5),
        'ffn_wd': nrm((DEPTH, 2, D_FF, D_MODEL), D_FF ** -0.5),
        'even_w_in': nrm((N_EVEN, D_MODEL, D_IN_EVEN), D_MODEL ** -0.5),
        'even_w_out': nrm((N_EVEN, D_MIX, D_MODEL), D_MIX ** -0.5),
        'a_mu': unif((N_EVEN, D_IN_A), 0.0, 1.0),
        'a_w0': unif((N_EVEN, D_A), -6.5, -1.5),
        'a_w_up': nrm((N_EVEN, LORA_W, D_A), 0.1 * LORA_W ** -0.5),
        'a_a0': nrm((N_EVEN, D_A), 0.1),
        'a_a_up': nrm((N_EVEN, LORA_A, D_A), 0.1 * LORA_A ** -0.5),
        'a_g_up': nrm((N_EVEN, LORA_G, D_A), LORA_G ** -0.5),
        'a_k_k': 0.85 + nrm((N_EVEN, D_A), 0.05),
        'a_k_a': 1.0 + nrm((N_EVEN, D_A), 0.05),
        'a_r_k': nrm((N_EVEN, H_A, HEAD_A), 0.1),
        'a_ln_w': 1.0 + nrm((N_EVEN, D_A), 0.02),
        'a_ln_b': nrm((N_EVEN, D_A), 0.02),
        'a_v0': 1.0 + nrm((N_VRES, D_A), 0.1),
        'a_v_dn': nrm((N_VRES, D_A, LORA_V), D_A ** -0.5),
        'a_v_up': nrm((N_VRES, LORA_V, D_A), 0.1 * LORA_V ** -0.5),
        'b_conv_w': nrm((N_EVEN, CONV_B, D_B), CONV_B ** -0.5),
        'odd_w_in': nrm((N_ODD, D_MODEL, D_IN_ODD), D_MODEL ** -0.5),
        'odd_w_out': nrm((N_ODD, D_MIX, D_MODEL), D_MIX ** -0.5),
        'c_conv_w': nrm((N_ODD, CONV_C, D_C), CONV_C ** -0.5),
        'c_conv_b': nrm((N_ODD, D_C), 0.02),
        'c_wa': nrm((N_ODD, H_C, BLK_C, BLK_C), BLK_C ** -0.5),
        'c_ba': nrm((N_ODD, H_C, BLK_C), 0.02),
        'c_wx': nrm((N_ODD, H_C, BLK_C, BLK_C), BLK_C ** -0.5),
        'c_bx': nrm((N_ODD, H_C, BLK_C), 0.02),
        'c_lam': jnp.log(lam_s) - jnp.log1p(-lam_s),
        'd_w': nrm((N_ODD, N_POOL, G_D, G_D), G_D ** -0.5),
        'd_scale': 1.0 + nrm((N_ODD, D_D), 0.1),
        'final_g': 1.0 + nrm((D_MODEL,), 0.02),
    }


def reference(x, norm_g, ffn_wg, ffn_wu, ffn_wd, even_w_in, even_w_out, a_mu, a_w0, a_w_up,
              a_a0, a_a_up, a_g_up, a_k_k, a_k_a, a_r_k, a_ln_w, a_ln_b, a_v0, a_v_dn, a_v_up,
              b_conv_w, odd_w_in, odd_w_out, c_conv_w, c_conv_b, c_wa, c_ba, c_wx, c_bx, c_lam,
              d_w, d_scale, final_g):
    dt = x.dtype
    v_first = None
    for layer in range(DEPTH):
        h = rmsnorm(x, norm_g[layer, 0])
        x = x + 0.5 * swiglu(h, ffn_wg[layer, 0], ffn_wu[layer, 0], ffn_wd[layer, 0])
        h = rmsnorm(x, norm_g[layer, 1])
        if layer % 2 == 0:
            e = layer // 2
            proj = h @ even_w_in[e]
            v_res = None if e == 0 else (a_v0[e - 1], a_v_dn[e - 1], a_v_up[e - 1])
            ya, v = rwkv7_time_mix(proj[..., :D_IN_A], a_mu[e], a_w0[e], a_w_up[e], a_a0[e],
                                   a_a_up[e], a_g_up[e], a_k_k[e], a_k_a[e], a_r_k[e],
                                   a_ln_w[e], a_ln_b[e], v_first, v_res)
            if e == 0:
                v_first = v
            yb = short_conv_mix(proj[..., D_IN_A:], b_conv_w[e])
            mix = jnp.concatenate([ya, yb], axis=-1).astype(dt) @ even_w_out[e]
        else:
            o = layer // 2
            proj = h @ odd_w_in[o]
            yc = rglru_mix(proj[..., :2 * D_C], c_conv_w[o], c_conv_b[o], c_wa[o], c_ba[o],
                           c_wx[o], c_bx[o], c_lam[o])
            yd = multiscale_pool_mix(proj[..., 2 * D_C:], d_w[o], d_scale[o])
            mix = jnp.concatenate([yc, yd], axis=-1).astype(dt) @ odd_w_out[o]
        x = x + mix
        h = rmsnorm(x, norm_g[layer, 2])
        x = x + 0.5 * swiglu(h, ffn_wg[layer, 1], ffn_wu[layer, 1], ffn_wd[layer, 1])
    return rmsnorm(x, final_g)
```

```cpp
#include <hip/hip_runtime.h>
#include <hip/hip_cooperative_groups.h>
#include <cstdio>
#include <cstdint>
namespace cg = cooperative_groups;
namespace pg8 {
#define PG8_LAS __attribute__((address_space(3)))
typedef unsigned short bf16_t;
typedef short bf16x8 __attribute__((ext_vector_type(8)));
typedef float f32x4 __attribute__((ext_vector_type(4)));
typedef unsigned u32x4 __attribute__((ext_vector_type(4)));
constexpr int BM = 256, BK = 64, HALF = 128, HTB = HALF * BK * 2  , STAGE_BYTES = 8 * HTB, NXCD = 8, WGM = 8;

__host__ __device__ __forceinline__ int lds_byte(int r, int c) { const int st = (r >> 4) * 2 + (c >> 5), rr = r & 15, cc = c & 31, ob = rr * 64 + cc * 2; return st * 1024 + (ob ^ (((ob >> 9) & 1) << 5)); }
__host__ __device__ __forceinline__ void stage_rc(int b, int& R, int& C) { const int st = b / 1024, sb = b % 1024, swz = sb ^ (((sb >> 9) & 1) << 5); R = (st >> 1) * 16 + swz / 64; C = (st & 1) * 32 + (swz % 64) / 2; }
__host__ __device__ __forceinline__ int perm32(int rho) { const int n = rho >> 4, i = rho & 15; return 8 * (i >> 2) + 4 * n + (i & 3); }

struct Unit { int pm, pn; };
struct Gemm { const bf16_t* A; const bf16_t* Bt; int M, N, K; };

struct StaticOrder {
    int nM, nN, nwg, G, c;
    __host__ __device__ void init(int M, int N, int G_, int c_) { nM = M / BM; nN = N / BM; nwg = nM * nN; G = G_; c = c_; }
    __host__ __device__ bool next(int i, Unit& u) const {
        const long L = (long)i * G + c; if (L >= nwg) return false;
        int wgid = (int)L; { const int q = nwg / NXCD, r = nwg % NXCD, xcd = wgid % NXCD, off = wgid / NXCD; wgid = (xcd < r ? xcd * (q + 1) : r * (q + 1) + (xcd - r) * q) + off; }
        const int nig = WGM * nN, gid = wgid / nig, fm = gid * WGM, gsz = (nM - fm) < WGM ? (nM - fm) : WGM;
        u.pm = fm + ((wgid % nig) % gsz); u.pn = (wgid % nig) / gsz; return true;
    }
    __device__ __forceinline__ void a_ready(const Unit&) const {}
    __device__ __forceinline__ void done(const Unit&) const {}
};

__device__ __forceinline__ unsigned cvt_pk_bf16(float lo, float hi) { unsigned r; asm volatile("v_cvt_pk_bf16_f32 %0, %1, %2" : "=v"(r) : "v"(lo), "v"(hi)); return r; }
typedef float f32x2 __attribute__((ext_vector_type(2)));

template <class Epi, class Sched, bool ALIGN_EPI = false, bool SP2 = false>
__device__ __forceinline__ void gemm_phase(PG8_LAS unsigned char* lds, const Gemm g, const Sched& S, const Epi& E) {
    int tid = threadIdx.x; asm volatile("" : "+v"(tid)); const int wid = __builtin_amdgcn_readfirstlane(tid >> 6), lane = tid & 63, wr = wid >> 2, wc = wid & 3, fr = lane & 15, fq = lane >> 4;
    const int K = g.K, nt = K / BK;
    unsigned voffA[2], voffB[2];
#pragma unroll
    for (int i = 0; i < 2; ++i) { int R, C; stage_rc(tid * 16 + i * 8192, R, C); const int Rb = Epi::PERM ? ((R & ~31) + perm32(R & 31)) : R;
        voffA[i] = (unsigned)(R * K + C) * 2u; voffB[i] = (unsigned)(Rb * K + C) * 2u; }
    const size_t kstep = (size_t)(BK * 2);
    const size_t hstep = (size_t)HALF * K * 2;
    const size_t tstep = 2 * hstep;
    const unsigned ldsw = (unsigned)wid * 1024u;
    const int aoff = lds_byte(wr * 64 + fr, fq * 8), boff = lds_byte(wc * 32 + fr, fq * 8);
#define PG8_SA(b, h) (((b) * 2 + (h)) * HTB)
#define PG8_SB(b, h) ((4 + (b) * 2 + (h)) * HTB)
#define PG8_STAGE(bufoff, gbase, voff) do { _Pragma("unroll") for (int _i = 0; _i < 2; ++_i) \
        __builtin_amdgcn_global_load_lds((const unsigned*)((const char*)(gbase) + (voff)[_i]), (PG8_LAS unsigned*)(lds + (bufoff) + ldsw + _i * 8192), 16, 0, 0); } while (0)
#define PG8_LDA(dst, b, h) do { _Pragma("unroll") for (int m = 0; m < 4; ++m) _Pragma("unroll") for (int k = 0; k < 2; ++k) dst[m][k] = *(const PG8_LAS bf16x8*)(lds + PG8_SA(b, h) + aoff + m * 2048 + k * 1024); } while (0)
#define PG8_LDB(dst, b, h) do { _Pragma("unroll") for (int n = 0; n < 2; ++n) _Pragma("unroll") for (int k = 0; k < 2; ++k) dst[n][k] = *(const PG8_LAS bf16x8*)(lds + PG8_SB(b, h) + boff + n * 2048 + k * 1024); } while (0)
#define PG8_MMA(ai, bj, At, Bt) do { __builtin_amdgcn_s_setprio(1); _Pragma("unroll") for (int m = 0; m < 4; ++m) _Pragma("unroll") for (int n = 0; n < 2; ++n) _Pragma("unroll") for (int k = 0; k < 2; ++k) \
        acc[ai][bj][m][n] = __builtin_amdgcn_mfma_f32_16x16x32_bf16(Bt[n][k], At[m][k], acc[ai][bj][m][n], 0, 0, 0); __builtin_amdgcn_s_setprio(0); } while (0)
#define PG8_WAIT_V(n) asm volatile("s_waitcnt vmcnt(" #n ")" ::: "memory")
#define PG8_WAIT_L(n) asm volatile("s_waitcnt lgkmcnt(" #n ")" ::: "memory")
#define PG8_BAR __builtin_amdgcn_s_barrier()
#define PG8_SCHED __builtin_amdgcn_sched_barrier(0)
    Unit cur, nxt; int ui = 0;
    if (!S.next(0, cur)) return;
    f32x4 acc[2][2][4][2];
#pragma unroll
    for (int a = 0; a < 2; ++a)
#pragma unroll
        for (int b = 0; b < 2; ++b)
#pragma unroll
            for (int m = 0; m < 4; ++m)
#pragma unroll
                for (int n = 0; n < 2; ++n) acc[a][b][m][n] = (f32x4){0.f, 0.f, 0.f, 0.f};
    bf16x8 At[4][2], B0[2][2], B1[2][2];
    const char* cA = (const char*)g.A + (size_t)cur.pm * tstep; const char* cB = (const char*)g.Bt + (size_t)cur.pn * tstep;
    S.a_ready(cur);
    if constexpr (SP2) {
        PG8_STAGE(PG8_SB(0, 0), cB, voffB); PG8_STAGE(PG8_SB(0, 1), cB + hstep, voffB); PG8_STAGE(PG8_SA(0, 0), cA, voffA); PG8_STAGE(PG8_SA(0, 1), cA + hstep, voffA);
        if (wr == 1) PG8_BAR;
        PG8_WAIT_V(2); PG8_BAR;
        PG8_STAGE(PG8_SB(1, 0), cB + kstep, voffB); PG8_STAGE(PG8_SA(1, 0), cA + kstep, voffA); PG8_STAGE(PG8_SB(1, 1), cB + hstep + kstep, voffB);
        PG8_WAIT_V(6); PG8_BAR;
    } else {
        PG8_STAGE(PG8_SB(0, 0), cB, voffB); PG8_STAGE(PG8_SA(0, 0), cA, voffA); PG8_STAGE(PG8_SB(0, 1), cB + hstep, voffB); PG8_STAGE(PG8_SA(0, 1), cA + hstep, voffA);
        if (wr == 1) PG8_BAR;
        PG8_WAIT_V(4); PG8_BAR;
        PG8_STAGE(PG8_SB(1, 0), cB + kstep, voffB); PG8_STAGE(PG8_SA(1, 0), cA + kstep, voffA); PG8_STAGE(PG8_SB(1, 1), cB + hstep + kstep, voffB);
        PG8_WAIT_V(6); PG8_BAR;
    }
    for (;;) {
        const bool has_next = S.next(ui + 1, nxt);
        const char* nA = has_next ? (const char*)g.A + (size_t)nxt.pm * tstep : cA; const char* nB = has_next ? (const char*)g.Bt + (size_t)nxt.pn * tstep : cB;
        for (int t = 0; t < nt; t += 2) {
            const bool last = (t == nt - 2);
            const char* a1 = cA + (size_t)(t + 1) * kstep;
            const char* a2 = last ? nA : cA + (size_t)(t + 2) * kstep; const char* b2 = last ? nB : cB + (size_t)(t + 2) * kstep;
            const char* a3 = a2 + kstep; const char* b3 = b2 + kstep;
            if (last && has_next) S.a_ready(nxt);
            if constexpr (SP2) {
            PG8_LDB(B0, 0, 0); PG8_LDB(B1, 0, 1); PG8_SCHED; PG8_LDA(At, 0, 0); PG8_STAGE(PG8_SA(1, 1), a1 + hstep, voffA);
            PG8_WAIT_V(8); PG8_WAIT_L(0); PG8_BAR; PG8_MMA(0, 0, At, B0); PG8_MMA(0, 1, At, B1); PG8_BAR; PG8_SCHED;
            PG8_LDA(At, 0, 1); PG8_STAGE(PG8_SB(0, 0), b2, voffB); PG8_STAGE(PG8_SB(0, 1), b2 + hstep, voffB); PG8_STAGE(PG8_SA(0, 0), a2, voffA);
            PG8_WAIT_V(8); PG8_WAIT_L(0); PG8_BAR; PG8_MMA(1, 0, At, B0); PG8_MMA(1, 1, At, B1); PG8_BAR; PG8_SCHED;
            PG8_LDB(B0, 1, 0); PG8_LDB(B1, 1, 1); PG8_SCHED; PG8_LDA(At, 1, 0); PG8_STAGE(PG8_SA(0, 1), a2 + hstep, voffA);
            PG8_WAIT_V(8); PG8_WAIT_L(0); PG8_BAR; PG8_MMA(0, 0, At, B0); PG8_MMA(0, 1, At, B1); PG8_BAR; PG8_SCHED;
            PG8_LDA(At, 1, 1); PG8_STAGE(PG8_SB(1, 0), b3, voffB); PG8_STAGE(PG8_SB(1, 1), b3 + hstep, voffB); PG8_STAGE(PG8_SA(1, 0), a3, voffA);
            PG8_WAIT_V(8); PG8_WAIT_L(0); PG8_BAR; PG8_MMA(1, 0, At, B0); PG8_MMA(1, 1, At, B1); PG8_BAR; PG8_SCHED;
            } else {
            PG8_LDB(B0, 0, 0); PG8_SCHED; PG8_LDA(At, 0, 0); PG8_STAGE(PG8_SA(1, 1), a1 + hstep, voffA);
            PG8_WAIT_L(8); PG8_BAR; PG8_WAIT_L(0); PG8_MMA(0, 0, At, B0); PG8_BAR; PG8_SCHED;
            PG8_LDB(B1, 0, 1); PG8_STAGE(PG8_SB(0, 0), b2, voffB);
            PG8_BAR; PG8_WAIT_L(0); PG8_MMA(0, 1, At, B1); PG8_BAR;
            PG8_LDA(At, 0, 1); PG8_STAGE(PG8_SA(0, 0), a2, voffA);
            PG8_BAR; PG8_WAIT_L(0); PG8_MMA(1, 0, At, B0); PG8_BAR; PG8_SCHED;
            PG8_STAGE(PG8_SB(0, 1), b2 + hstep, voffB);
            PG8_WAIT_V(6); PG8_BAR; PG8_MMA(1, 1, At, B1); PG8_BAR;
            PG8_LDB(B0, 1, 0); PG8_SCHED; PG8_LDA(At, 1, 0); PG8_STAGE(PG8_SA(0, 1), a2 + hstep, voffA);
            PG8_WAIT_L(8); PG8_BAR; PG8_WAIT_L(0); PG8_MMA(0, 0, At, B0); PG8_BAR; PG8_SCHED;
            PG8_LDB(B1, 1, 1); PG8_STAGE(PG8_SB(1, 0), b3, voffB);
            PG8_BAR; PG8_WAIT_L(0); PG8_MMA(0, 1, At, B1); PG8_BAR;
            PG8_LDA(At, 1, 1); PG8_STAGE(PG8_SA(1, 0), a3, voffA);
            PG8_BAR; PG8_WAIT_L(0); PG8_MMA(1, 0, At, B0); PG8_BAR; PG8_SCHED;
            PG8_STAGE(PG8_SB(1, 1), b3 + hstep, voffB);
            PG8_WAIT_V(6); PG8_BAR; PG8_MMA(1, 1, At, B1); PG8_BAR;
            }
        }
        if constexpr (ALIGN_EPI) { if (wr == 0) PG8_BAR; }
        if constexpr (!Epi::AFTER_DRAIN) { E(acc, cur, wr, wc, fr, fq); S.done(cur); }
        if (!has_next) break;
#pragma unroll
        for (int a = 0; a < 2; ++a)
#pragma unroll
            for (int b = 0; b < 2; ++b)
#pragma unroll
                for (int m = 0; m < 4; ++m)
#pragma unroll
                    for (int n = 0; n < 2; ++n) acc[a][b][m][n] = (f32x4){0.f, 0.f, 0.f, 0.f};
        cur = nxt; cA = nA; cB = nB; ++ui;
        if constexpr (ALIGN_EPI) { if (wr == 1) PG8_BAR; }
    }
    PG8_WAIT_V(0);
    if constexpr (!ALIGN_EPI) { if (wr == 0) PG8_BAR; }
    PG8_BAR;
    if constexpr (Epi::AFTER_DRAIN) { E.fused(acc, cur, wr, wc, fr, fq, lds, wid, lane); S.done(cur); }
#undef PG8_SA
#undef PG8_SB
#undef PG8_STAGE
#undef PG8_LDA
#undef PG8_LDB
#undef PG8_MMA
#undef PG8_WAIT_V
#undef PG8_WAIT_L
#undef PG8_BAR
#undef PG8_SCHED
}
}

#define LAS __attribute__((address_space(3)))
typedef unsigned short bf16;
typedef float f32x2 __attribute__((ext_vector_type(2)));
typedef float f32x4 __attribute__((ext_vector_type(4)));
typedef unsigned u32x4 __attribute__((ext_vector_type(4)));
typedef unsigned u32x2 __attribute__((ext_vector_type(2)));

constexpr int T = 16384, D = 1024, FF = 2816, DEPTH = 4;
constexpr int DINA = 1792, DINE = 3328, DINO = 1536;
constexpr int NTHREADS = 512, NWAVES = 8;
constexpr int LDS_BYTES = 135168;
constexpr int LCH = 64, NCH = T / LCH;
constexpr int RLCH = 64, RNCH = T / RLCH;

enum { I_X = 0, I_NORMG, I_WG, I_WU, I_WD, I_EWIN, I_EWOUT, I_AMU, I_AW0, I_AWUP, I_AA0, I_AAUP, I_AGUP, I_AKK, I_AKA, I_ARK, I_ALNW, I_ALNB,
       I_AV0, I_AVDN, I_AVUP, I_BCONV, I_OWIN, I_OWOUT, I_CCONVW, I_CCONVB, I_CWA, I_CBA, I_CWX, I_CBX, I_CLAM, I_DW, I_DSCALE, I_FINALG, N_IN };

constexpr size_t OFF_W = 0, SZ_W = 17301504;
constexpr size_t OFF_WB = OFF_W + 11534336;
constexpr size_t OFF_X = OFF_W + SZ_W, SZ_X = (size_t)T * D * 4;
constexpr size_t OFF_VF = OFF_X + SZ_X, SZ_VF = (size_t)T * 512 * 2;
constexpr size_t OFF_H = OFF_VF + SZ_VF, SZ_H = (size_t)T * D * 2;
constexpr size_t OFF_U = OFF_H + SZ_H;
constexpr size_t OFF_ACT = OFF_U;
constexpr size_t OFF_PA = OFF_U;
constexpr size_t OFF_DEC = OFF_PA + (size_t)T * DINA * 2;
constexpr size_t OFF_A16 = OFF_DEC + (size_t)T * 512 * 4;
constexpr size_t OFF_PB = OFF_DEC;
constexpr size_t OFF_V16 = OFF_A16 + (size_t)T * 512 * 2;
constexpr size_t OFF_G16 = OFF_V16 + (size_t)T * 512 * 2;
constexpr size_t OFF_MCM = OFF_G16 + (size_t)T * 512 * 2;
constexpr size_t OFF_MIXE = OFF_MCM;
constexpr size_t OFF_MCC = OFF_MCM + (size_t)NCH * 8 * 4096 * 4;
constexpr size_t SZ_U = (OFF_MCC + (size_t)NCH * 8 * 4096 * 4) - OFF_U;
constexpr size_t OFF_PO = OFF_U;
constexpr size_t OFF_LA = OFF_PO + (size_t)T * DINO * 2;
constexpr size_t OFF_LBX = OFF_LA + (size_t)T * 512 * 4;
constexpr size_t OFF_CHA = OFF_LBX + (size_t)T * 512 * 4;
constexpr size_t OFF_CHB = OFF_CHA + (size_t)NCH * 512 * 4;
constexpr size_t OFF_CAR = OFF_CHB + (size_t)NCH * 512 * 4;
constexpr size_t OFF_MIXO = OFF_CAR + (size_t)NCH * 512 * 4;
constexpr size_t OFF_UC = OFF_MIXO + (size_t)T * D * 2;
constexpr size_t OFF_PD = OFF_UC + (size_t)T * 512 * 2;
constexpr size_t OFF_CTL = OFF_U + SZ_U, SZ_CTL = 16384;
constexpr size_t OFF_MG = OFF_CTL + SZ_CTL, OFF_CG = OFF_MG + 2097152;
constexpr size_t OFF_WCAT = OFF_CG + 2097152;
constexpr size_t OFF_WVDN = OFF_WCAT + (size_t)1536 * 256 * 2;
constexpr size_t OFF_WVUP = OFF_WVDN + (size_t)256 * 512 * 2;
constexpr size_t OFF_LIN = OFF_WVUP + (size_t)512 * 256 * 2;
constexpr size_t OFF_LOW = OFF_LIN + (size_t)T * 256 * 2;
constexpr size_t OFF_WG = OFF_LOW + (size_t)T * 256 * 2;
constexpr size_t OFF_WP = OFF_WG + (size_t)1024 * 512 * 2;
constexpr size_t WS_END = OFF_WP + (size_t)512 * 512 * 2;
static_assert(OFF_PD + (size_t)T * 512 * 2 <= OFF_CTL, "odd map");
static_assert((size_t)T * FF * 2 <= SZ_U, "act map");
static_assert((size_t)T * DINO * 2 == (size_t)T * 512 * 4 + (size_t)T * 512 * 2, "PB overlay");
static_assert((size_t)T * D * 2 <= (size_t)NCH * 8 * 4096 * 4, "MIX overlay");

struct Params { const float* in[N_IN]; float* out; unsigned char* ws; int ph_lo, ph_hi; };

__device__ __forceinline__ float bf2f(bf16 b) { return __uint_as_float(((unsigned)b) << 16); }
__device__ __forceinline__ unsigned f2bf(float f) { unsigned u = __float_as_uint(f); return (u + 0x7fffu + ((u >> 16) & 1u)) >> 16; }
__device__ __forceinline__ unsigned pk2(float lo, float hi) { return f2bf(lo) | (f2bf(hi) << 16); }
template <int CTRL> __device__ __forceinline__ float dpp_mov(float v) { return __int_as_float(__builtin_amdgcn_update_dpp(0, __float_as_int(v), CTRL, 0xF, 0xF, true)); }
__device__ __forceinline__ float wave_sum(float v) {
    v += dpp_mov<0xB1>(v); v += dpp_mov<0x4E>(v); v += dpp_mov<0x141>(v); v += dpp_mov<0x140>(v);
    const float s0 = __int_as_float(__builtin_amdgcn_readlane(__float_as_int(v), 0)), s1 = __int_as_float(__builtin_amdgcn_readlane(__float_as_int(v), 16));
    const float s2 = __int_as_float(__builtin_amdgcn_readlane(__float_as_int(v), 32)), s3 = __int_as_float(__builtin_amdgcn_readlane(__float_as_int(v), 48));
    return (s0 + s1) + (s2 + s3);
}
__device__ __forceinline__ float frcp(float x) { return __builtin_amdgcn_rcpf(x); }
__device__ __forceinline__ float frsq(float x) { return __builtin_amdgcn_rsqf(x); }
__device__ __forceinline__ float sigm(float x) { return frcp(1.f + __expf(-x)); }
__device__ __forceinline__ float tanh_fast(float x) { return 1.f - 2.f * frcp(1.f + __expf(2.f * x)); }
#define LDS_WAIT() asm volatile("s_waitcnt lgkmcnt(0)" ::: "memory")
template <class Tp> __device__ __forceinline__ const Tp* opaque(const Tp* p) { asm volatile("" : "+v"(p)); return p; }

template <int K> __device__ __forceinline__ float dot_bcast(const LAS float* x, const f32x2 (&w2)[K / 2]) {
    f32x2 a0 = {0.f, 0.f}, a1 = {0.f, 0.f};
#pragma unroll
    for (int q = 0; q < K / 4; ++q) {
        const f32x4 v = *(const LAS f32x4*)(x + 4 * q);
        a0 += (f32x2){v.x, v.y} * w2[2 * q];
        a1 += (f32x2){v.z, v.w} * w2[2 * q + 1];
    }
    return (a0.x + a0.y) + (a1.x + a1.y);
}

struct EpiSwiglu {
    static constexpr bool PERM = true, AFTER_DRAIN = false;
    bf16* O;
    __device__ __forceinline__ void operator()(const f32x4 (&acc)[2][2][4][2], const pg8::Unit& u, int wr, int wc, int fr, int fq) const {
        const int row0 = u.pm * 256 + wr * 64 + fr, col0 = u.pn * 128 + wc * 32 + 8 * fq;
#pragma unroll
        for (int ai = 0; ai < 2; ++ai)
#pragma unroll
            for (int m = 0; m < 4; ++m) {
                bf16* rowp = O + (size_t)(row0 + ai * 128 + m * 16) * FF + col0;
                float r[8];
#pragma unroll
                for (int n = 0; n < 2; ++n)
#pragma unroll
                    for (int i = 0; i < 4; ++i) { const float g = acc[ai][0][m][n][i], up = acc[ai][1][m][n][i]; r[n * 4 + i] = g * up * frcp(1.f + __expf(-g)); }
                u32x4 w; w.x = pg8::cvt_pk_bf16(r[0], r[1]); w.y = pg8::cvt_pk_bf16(r[2], r[3]); w.z = pg8::cvt_pk_bf16(r[4], r[5]); w.w = pg8::cvt_pk_bf16(r[6], r[7]);
                *(u32x4*)rowp = w;
            }
    }
};
struct EpiResid {
    static constexpr bool PERM = false, AFTER_DRAIN = false;
    const float* Xin; float* Xout; float scale;
    __device__ __forceinline__ void operator()(const f32x4 (&acc)[2][2][4][2], const pg8::Unit& u, int wr, int wc, int fr, int fq) const {
        const int row0 = u.pm * 256 + wr * 64 + fr, col0 = u.pn * 256 + wc * 32 + 4 * fq;
#pragma unroll
        for (int ai = 0; ai < 2; ++ai)
#pragma unroll
            for (int mh = 0; mh < 2; ++mh) {
                f32x4 xi[2][2][2];
#pragma unroll
                for (int m = 0; m < 2; ++m)
#pragma unroll
                    for (int bj = 0; bj < 2; ++bj)
#pragma unroll
                        for (int n = 0; n < 2; ++n) xi[m][bj][n] = *(const f32x4*)(Xin + (size_t)(row0 + ai * 128 + (2 * mh + m) * 16) * D + col0 + bj * 128 + n * 16);
                __builtin_amdgcn_sched_barrier(0);
#pragma unroll
                for (int m = 0; m < 2; ++m)
#pragma unroll
                    for (int bj = 0; bj < 2; ++bj)
#pragma unroll
                        for (int n = 0; n < 2; ++n) *(f32x4*)(Xout + (size_t)(row0 + ai * 128 + (2 * mh + m) * 16) * D + col0 + bj * 128 + n * 16) = xi[m][bj][n] + acc[ai][bj][2 * mh + m][n] * scale;
                __builtin_amdgcn_sched_barrier(0);
            }
    }
};
struct EpiStoreBf16 {
    static constexpr bool PERM = true, AFTER_DRAIN = false;
    bf16* O; int ldc;
    __device__ __forceinline__ void operator()(const f32x4 (&acc)[2][2][4][2], const pg8::Unit& u, int wr, int wc, int fr, int fq) const {
        const int row0 = u.pm * 256 + wr * 64 + fr, col0 = u.pn * 256 + wc * 32 + 8 * fq;
#pragma unroll
        for (int ai = 0; ai < 2; ++ai)
#pragma unroll
            for (int m = 0; m < 4; ++m) {
                bf16* rowp = O + (size_t)(row0 + ai * 128 + m * 16) * ldc + col0;
#pragma unroll
                for (int bj = 0; bj < 2; ++bj) { const f32x4 v0 = acc[ai][bj][m][0], v1 = acc[ai][bj][m][1];
                    u32x4 w; w.x = pg8::cvt_pk_bf16(v0[0], v0[1]); w.y = pg8::cvt_pk_bf16(v0[2], v0[3]); w.z = pg8::cvt_pk_bf16(v1[0], v1[1]); w.w = pg8::cvt_pk_bf16(v1[2], v1[3]);
                    *(u32x4*)(rowp + bj * 128) = w; }
            }
    }
};
template <class Epi> __device__ __forceinline__ void run_gemm(LAS unsigned char* lds, const bf16* A, const bf16* Bt, int M, int N, int K, const Epi& E) {
    asm volatile("" : "+s"(K));
    pg8::Gemm g{A, Bt, M, N, K}; pg8::StaticOrder S; S.init(M, N, (int)gridDim.x, (int)blockIdx.x);
    pg8::gemm_phase<Epi, pg8::StaticOrder, true, true>(lds, g, S, E);
}

__device__ __forceinline__ void transpose_item(const float* __restrict__ W, int K, int N, bf16* WT, int mode, LAS float* scr, int item, int lane) {
    const int nblk = N / 32, kb = item / nblk, nb = item % nblk, k0 = 64 * kb, n0 = 32 * nb;
    float tv[32];
#pragma unroll
    for (int i = 0; i < 32; ++i) { const int kk = 2 * i + (lane >> 5); tv[i] = W[(size_t)(k0 + kk) * N + n0 + (lane & 31)]; }
    __builtin_amdgcn_sched_barrier(0);
#pragma unroll
    for (int i = 0; i < 32; ++i) { const int kk = 2 * i + (lane >> 5); scr[kk * 33 + (lane & 31)] = tv[i]; }
    LDS_WAIT();
    const int c = lane & 7;
    const int drow0 = mode == 0 ? n0 : (256 * (n0 >> 7) + (n0 & 127) + (mode == 2 ? 128 : 0));
#pragma unroll
    for (int j = 0; j < 4; ++j) { const int n = (lane >> 3) + 8 * j; const LAS float* s = scr + (8 * c) * 33 + n;
        u32x4 o; o.x = pk2(s[0 * 33], s[1 * 33]); o.y = pk2(s[2 * 33], s[3 * 33]); o.z = pk2(s[4 * 33], s[5 * 33]); o.w = pk2(s[6 * 33], s[7 * 33]);
        *(u32x4*)(WT + (size_t)(drow0 + n) * K + k0 + 8 * c) = o; }
    LDS_WAIT();
}
__device__ __forceinline__ void conv_matrix(const float* W, int K, int N, bf16* WT, int mode, LAS float* scr, int gw, int ngw, int lane) {
    const int items = (K / 64) * (N / 32);
    for (int it = gw; it < items; it += ngw) transpose_item(W, K, N, WT, mode, scr, it, lane);
}
__device__ __forceinline__ void rmsnorm_rows(const float* X, const float* g, bf16* H, float* Of, int gw, int ngw, int lane) {
    f32x4 gv[4];
#pragma unroll
    for (int j = 0; j < 4; ++j) gv[j] = *(const f32x4*)(g + 4 * lane + 256 * j);
    for (int row0 = 4 * gw; row0 < T; row0 += 4 * ngw) {
        f32x4 v[4][4]; float s[4] = {0.f, 0.f, 0.f, 0.f};
#pragma unroll
        for (int r = 0; r < 4; ++r)
#pragma unroll
            for (int j = 0; j < 4; ++j) v[r][j] = *(const f32x4*)(X + (size_t)(row0 + r) * D + 4 * lane + 256 * j);
        __builtin_amdgcn_sched_barrier(0);
#pragma unroll
        for (int r = 0; r < 4; ++r)
#pragma unroll
            for (int j = 0; j < 4; ++j) s[r] += (v[r][j].x * v[r][j].x + v[r][j].y * v[r][j].y) + (v[r][j].z * v[r][j].z + v[r][j].w * v[r][j].w);
#pragma unroll
        for (int r = 0; r < 4; ++r) {
            const float rstd = frsq(wave_sum(s[r]) * (1.f / D) + 1e-6f);
#pragma unroll
            for (int j = 0; j < 4; ++j) {
                const f32x4 o = v[r][j] * rstd * gv[j];
                if (Of) *(f32x4*)(Of + (size_t)(row0 + r) * D + 4 * lane + 256 * j) = o;
                else { u32x2 w; w.x = pk2(o.x, o.y); w.y = pk2(o.z, o.w); *(u32x2*)(H + (size_t)(row0 + r) * D + 4 * lane + 256 * j) = w; }
            }
        }
    }
}

__device__ __forceinline__ void stage_images(const Params& P, int odd, int idx) {
    unsigned char* ws = P.ws;
    int tid = threadIdx.x; asm volatile("" : "+v"(tid));
    const size_t gt = (size_t)blockIdx.x * NTHREADS + tid, ngt = (size_t)gridDim.x * NTHREADS;
    if (!odd) {
        const int e = idx;
    {
        bf16* WC = (bf16*)(ws + OFF_WCAT); bf16* WDN = (bf16*)(ws + OFF_WVDN); bf16* WUP = (bf16*)(ws + OFF_WVUP);
        const float* w_up = P.in[I_AWUP] + (size_t)e * 64 * 512; const float* a_up = P.in[I_AAUP] + (size_t)e * 64 * 512; const float* g_up = P.in[I_AGUP] + (size_t)e * 128 * 512;
        for (size_t i = gt; i < (size_t)1536 * 256; i += ngt) {
            const int n = (int)(i >> 8), k = (int)(i & 255); float v = 0.f;
            if (n < 512) { if (k < 64) v = w_up[(size_t)k * 512 + n]; }
            else if (n < 1024) { if (k >= 64 && k < 128) v = a_up[(size_t)(k - 64) * 512 + (n - 512)]; }
            else { if (k >= 128) v = g_up[(size_t)(k - 128) * 512 + (n - 1024)]; }
            WC[i] = (bf16)f2bf(v);
        }
        if (e > 0) {
            const float* v_dn = P.in[I_AVDN] + (size_t)(e - 1) * 512 * 32; const float* v_up = P.in[I_AVUP] + (size_t)(e - 1) * 32 * 512;
            for (size_t i = gt; i < (size_t)256 * 512; i += ngt) { const int n = (int)(i >> 9), k = (int)(i & 511); WDN[i] = (bf16)f2bf(n < 32 ? v_dn[(size_t)k * 32 + n] : 0.f); }
            for (size_t i = gt; i < (size_t)512 * 256; i += ngt) { const int n = (int)(i >> 8), k = (int)(i & 255); WUP[i] = (bf16)f2bf(k < 32 ? v_up[(size_t)k * 512 + n] : 0.f); }
        }
    }
    } else {
        const int o = idx;
    {
        bf16* WG = (bf16*)(ws + OFF_WG); bf16* WP = (bf16*)(ws + OFF_WP);
        const float* wa = P.in[I_CWA] + (size_t)o * 8 * 4096; const float* wx = P.in[I_CWX] + (size_t)o * 8 * 4096; const float* dw = P.in[I_DW] + (size_t)o * 4 * 16384;
        for (size_t i = gt; i < (size_t)1024 * 512; i += ngt) {
            const int n = (int)(i >> 9), k = (int)(i & 511), nn = n & 511, h = nn >> 6;
            float v = 0.f;
            if ((k >> 6) == h) v = (n < 512 ? wa : wx)[(size_t)h * 4096 + (size_t)(k & 63) * 64 + (nn & 63)];
            WG[i] = (bf16)f2bf(v);
        }
        for (size_t i = gt; i < (size_t)512 * 512; i += ngt) {
            const int n = (int)(i >> 9), k = (int)(i & 511), g = n >> 7;
            WP[i] = (bf16)f2bf((k >> 7) == g ? dw[(size_t)g * 16384 + (size_t)(k & 127) * 128 + (n & 127)] : 0.f);
        }
    }
    }
}
__device__ __forceinline__ void stage_prepE(const Params& P, int e) {
    unsigned char* ws = P.ws;
    const bf16* PA = (const bf16*)(ws + OFF_PA);
    bf16* LIN = (bf16*)(ws + OFF_LIN); bf16* VDST = (bf16*)(ws + (e == 0 ? OFF_VF : OFF_V16));
    const float* mu = P.in[I_AMU] + (size_t)e * DINA;
    int tid = threadIdx.x; asm volatile("" : "+v"(tid));
    const size_t gt = (size_t)blockIdx.x * NTHREADS + tid, ngt = (size_t)gridDim.x * NTHREADS;
    stage_images(P, 0, e);
    for (size_t it = gt; it < (size_t)(T / 16) * 768; it += ngt) {
        const int tile = (int)(it / 768), c = (int)(it % 768), t0 = tile * 16;
        const int col = c < 256 ? 1536 + c : 1024 + (c - 256);
        const float m = mu[col];
        float pv[17]; bf16 raw[17];
#pragma unroll
        for (int i = 0; i < 17; ++i) { const int tg = t0 - 1 + i; raw[i] = PA[(size_t)(tg > 0 ? tg : 0) * DINA + col]; }
        __builtin_amdgcn_sched_barrier(0);
#pragma unroll
        for (int i = 0; i < 17; ++i) { const int tg = t0 - 1 + i; pv[i] = tg >= 0 ? bf2f(raw[i]) : 0.f; }
#pragma unroll
        for (int i = 0; i < 16; ++i) {
            float x = pv[i + 1] + (pv[i] - pv[i + 1]) * m;
            if (c < 256) { if (c < 64) x = tanh_fast(x); else if (c >= 128) x = sigm(x); LIN[(size_t)(t0 + i) * 256 + c] = (bf16)f2bf(x); }
            else VDST[(size_t)(t0 + i) * 512 + (c - 256)] = (bf16)f2bf(x);
        }
    }
}
struct EpiLora {
    static constexpr bool PERM = true, AFTER_DRAIN = false;
    unsigned char* wsb; const float* w0; const float* a0;
    __device__ __forceinline__ void operator()(const f32x4 (&acc)[2][2][4][2], const pg8::Unit& u, int wr, int wc, int fr, int fq) const {
        const int row0 = u.pm * 256 + wr * 64 + fr, kind = u.pn >> 1, colb = (u.pn & 1) * 256 + wc * 32 + 8 * fq;
        float* DEC = (float*)(wsb + OFF_DEC); bf16* O16 = (bf16*)(wsb + (kind == 1 ? OFF_A16 : OFF_G16));
#pragma unroll
        for (int bj = 0; bj < 2; ++bj) {
            const int col = colb + bj * 128;
            f32x4 b0 = {0.f, 0.f, 0.f, 0.f}, b1 = {0.f, 0.f, 0.f, 0.f};
            if (kind == 0) { b0 = *(const f32x4*)(w0 + col); b1 = *(const f32x4*)(w0 + col + 4); }
            else if (kind == 1) { b0 = *(const f32x4*)(a0 + col); b1 = *(const f32x4*)(a0 + col + 4); }
#pragma unroll
            for (int ai = 0; ai < 2; ++ai)
#pragma unroll
                for (int m = 0; m < 4; ++m) {
                    const size_t off = (size_t)(row0 + ai * 128 + m * 16) * 512 + col;
                    f32x4 v0 = acc[ai][bj][m][0] + b0, v1 = acc[ai][bj][m][1] + b1;
                    if (kind == 0) {
#pragma unroll
                        for (int i = 0; i < 4; ++i) {
                            { const float z = -v0[i]; const float sp_ = fmaxf(z, 0.f) + __logf(1.f + __expf(-fabsf(z))); v0[i] = __expf(-__expf(-sp_ - 0.5f)); }
                            { const float z = -v1[i]; const float sp_ = fmaxf(z, 0.f) + __logf(1.f + __expf(-fabsf(z))); v1[i] = __expf(-__expf(-sp_ - 0.5f)); }
                        }
                        *(f32x4*)(DEC + off) = v0; *(f32x4*)(DEC + off + 4) = v1;
                    } else {
                        if (kind == 1) {
#pragma unroll
                            for (int i = 0; i < 4; ++i) { v0[i] = sigm(v0[i]); v1[i] = sigm(v1[i]); }
                        }
                        u32x4 w; w.x = pg8::cvt_pk_bf16(v0[0], v0[1]); w.y = pg8::cvt_pk_bf16(v0[2], v0[3]); w.z = pg8::cvt_pk_bf16(v1[0], v1[1]); w.w = pg8::cvt_pk_bf16(v1[2], v1[3]);
                        *(u32x4*)(O16 + off) = w;
                    }
                }
        }
    }
};
struct EpiVres {
    static constexpr bool PERM = true, AFTER_DRAIN = false;
    bf16* V; const bf16* VF; const float* v0;
    __device__ __forceinline__ void operator()(const f32x4 (&acc)[2][2][4][2], const pg8::Unit& u, int wr, int wc, int fr, int fq) const {
        const int row0 = u.pm * 256 + wr * 64 + fr, colb = u.pn * 256 + wc * 32 + 8 * fq;
#pragma unroll
        for (int bj = 0; bj < 2; ++bj) {
            const int col = colb + bj * 128;
            const f32x4 b0 = *(const f32x4*)(v0 + col), b1 = *(const f32x4*)(v0 + col + 4);
#pragma unroll
            for (int ai = 0; ai < 2; ++ai) {
                u32x4 vr[4], fr_[4];
#pragma unroll
                for (int m = 0; m < 4; ++m) { const size_t off = (size_t)(row0 + ai * 128 + m * 16) * 512 + col; vr[m] = *(const u32x4*)(V + off); fr_[m] = *(const u32x4*)(VF + off); }
                __builtin_amdgcn_sched_barrier(0);
#pragma unroll
                for (int m = 0; m < 4; ++m) {
                    const size_t off = (size_t)(row0 + ai * 128 + m * 16) * 512 + col;
                    const f32x4 g0 = acc[ai][bj][m][0] + b0, g1 = acc[ai][bj][m][1] + b1;
                    float o[8];
#pragma unroll
                    for (int i = 0; i < 8; ++i) {
                        const unsigned vw = vr[m][i >> 1], fw = fr_[m][i >> 1];
                        const float v = __uint_as_float((i & 1) ? (vw & 0xffff0000u) : (vw << 16)), vf = __uint_as_float((i & 1) ? (fw & 0xffff0000u) : (fw << 16));
                        const float gate = sigm(i < 4 ? g0[i] : g1[i - 4]);
                        o[i] = v + (vf - v) * gate;
                    }
                    u32x4 w; w.x = pg8::cvt_pk_bf16(o[0], o[1]); w.y = pg8::cvt_pk_bf16(o[2], o[3]); w.z = pg8::cvt_pk_bf16(o[4], o[5]); w.w = pg8::cvt_pk_bf16(o[6], o[7]);
                    *(u32x4*)(V + off) = w;
                }
                __builtin_amdgcn_sched_barrier(0);
            }
        }
    }
};

template <int MODE> __device__ __forceinline__ void rwkv_item(const Params& P, int e, int c, int h, LAS float* slab, int lane) {
    unsigned char* ws = P.ws;
    const bf16* PA = (const bf16*)(ws + OFF_PA);
    const float* DEC = (const float*)(ws + OFF_DEC); const bf16* A16 = (const bf16*)(ws + OFF_A16); const bf16* G16 = (const bf16*)(ws + OFF_G16);
    const bf16* V16 = (const bf16*)(ws + (e == 0 ? OFF_VF : OFF_V16));
    float* MCM = (float*)(ws + OFF_MCM); float* MCC = (float*)(ws + OFF_MCC); bf16* MIX = (bf16*)(ws + OFF_MIXE);
    const int ch = h * 64 + lane;
    const float mu_r = P.in[I_AMU][(size_t)e * DINA + ch], mu_k = P.in[I_AMU][(size_t)e * DINA + 512 + ch];
    const float kkw = P.in[I_AKK][e * 512 + ch], ka = P.in[I_AKA][e * 512 + ch], rk = P.in[I_ARK][e * 512 + ch];
    const float lnw = P.in[I_ALNW][e * 512 + ch], lnb = P.in[I_ALNB][e * 512 + ch];
    constexpr int SB = MODE == 0 ? 4 : 8;
    f32x2 S2[32], C2[MODE == 0 ? 32 : 1];
    const size_t rowoff = (((size_t)c * 8 + h) * 64 + lane) * 64;
    if (MODE == 0) {
#pragma unroll
        for (int i = 0; i < 32; ++i) { S2[i] = (f32x2){(2 * i) == lane ? 1.f : 0.f, (2 * i + 1) == lane ? 1.f : 0.f}; C2[i] = (f32x2){0.f, 0.f}; }
    } else {
#pragma unroll
        for (int q = 0; q < 16; ++q) { const f32x4 v = *(const f32x4*)(MCC + rowoff + 4 * q); S2[2 * q] = (f32x2){v.x, v.y}; S2[2 * q + 1] = (f32x2){v.z, v.w}; }
    }
    float r1[SB + 1], k1[SB + 1], vv[SB], dd[SB], aa[SB], gg[MODE == 1 ? SB : 1];
#define RW_LOAD(tb_) do { { const int tp_ = (tb_) - 1; const size_t pq_ = (size_t)(tp_ > 0 ? tp_ : 0) * DINA + ch; const float ra_ = bf2f(PA[pq_]), ka_ = bf2f(PA[pq_ + 512]); r1[0] = tp_ >= 0 ? ra_ : 0.f; k1[0] = tp_ >= 0 ? ka_ : 0.f; } \
        _Pragma("unroll") for (int s_ = 0; s_ < SB; ++s_) { const int t_ = (tb_) + s_; const size_t pr_ = (size_t)t_ * DINA + ch; \
        r1[s_ + 1] = bf2f(PA[pr_]); k1[s_ + 1] = bf2f(PA[pr_ + 512]); \
        vv[s_] = bf2f(V16[(size_t)t_ * 512 + ch]); dd[s_] = DEC[(size_t)t_ * 512 + ch]; aa[s_] = bf2f(A16[(size_t)t_ * 512 + ch]); \
        if (MODE == 1) gg[s_] = bf2f(G16[(size_t)t_ * 512 + ch]); } } while (0)
    if (MODE == 1) RW_LOAD(c * RLCH);
    for (int sb = 0; sb < RLCH / SB; ++sb) {
        const int tb = c * RLCH + sb * SB;
        if (MODE == 0) RW_LOAD(tb);
#pragma unroll
        for (int s = 0; s < SB; ++s) {
            const float r = r1[s + 1] + (r1[s] - r1[s + 1]) * mu_r, k = k1[s + 1] + (k1[s] - k1[s + 1]) * mu_k, a = aa[s];
            float kk = k * kkw;
            const float ss = wave_sum(kk * kk);
            kk *= frsq(fmaxf(ss, 1e-24f));
            const float b = kk * a, kp = k * (1.f + (a - 1.f) * ka);
            LAS float* st = slab + s * 512;
            st[lane] = dd[s]; st[64 + lane] = kk; st[128 + lane] = b; st[192 + lane] = kp; st[256 + lane] = r; st[320 + lane] = vv[s];
            if (MODE == 1) { st[384 + lane] = wave_sum(r * kp * rk); st[448 + lane] = gg[s]; }
        }
        LDS_WAIT();
        if (MODE == 1 && sb + 1 < RLCH / SB) RW_LOAD(tb + SB);
#pragma unroll 1
        for (int s = 0; s < SB; ++s) {
            const LAS float* st = slab + s * 512;
            f32x2 aS0 = {0.f, 0.f}, aS1 = {0.f, 0.f}, aC0 = {0.f, 0.f}, aC1 = {0.f, 0.f};
            constexpr int DB = 4, UB = 2;
            constexpr int NDB = 16 / DB, NUB = 16 / UB;
            constexpr int NB = MODE == 1 ? 2 : 1;
            f32x4 kd[NB][DB];
            f32x4 wq[NB][UB], bq[NB][UB], kq[NB][UB], rq[NB][MODE == 1 ? UB : 1];
#define RW_LD_DOT(buf, hb) do { _Pragma("unroll") for (int q_ = 0; q_ < DB; ++q_) kd[buf][q_] = *(const LAS f32x4*)(st + 64 + 4 * (DB * (hb) + q_)); } while (0)
#define RW_LD_UPD(buf, qb) do { _Pragma("unroll") for (int q_ = 0; q_ < UB; ++q_) { const int qq_ = UB * (qb) + q_; \
                wq[buf][q_] = *(const LAS f32x4*)(st + 4 * qq_); bq[buf][q_] = *(const LAS f32x4*)(st + 128 + 4 * qq_); kq[buf][q_] = *(const LAS f32x4*)(st + 192 + 4 * qq_); \
                if (MODE == 1) rq[buf][q_] = *(const LAS f32x4*)(st + 256 + 4 * qq_); } } while (0)
            if (NB == 2) RW_LD_DOT(0, 0);
            const float v = st[320 + lane];
#pragma unroll
            for (int hb = 0; hb < NDB; ++hb) {
                if (NB == 2) { if (hb + 1 < NDB) RW_LD_DOT((hb + 1) & 1, hb + 1); else RW_LD_UPD(0, 0); } else RW_LD_DOT(0, hb);
                __builtin_amdgcn_sched_barrier(0);
#pragma unroll
                for (int q = 0; q < DB; ++q) {
                    const int qq = DB * hb + q; const f32x4 k4 = kd[hb & (NB - 1)][q];
                    aS0 += S2[2 * qq] * (f32x2){k4.x, k4.y}; aS1 += S2[2 * qq + 1] * (f32x2){k4.z, k4.w};
                    if (MODE == 0) { aC0 += C2[2 * qq] * (f32x2){k4.x, k4.y}; aC1 += C2[2 * qq + 1] * (f32x2){k4.z, k4.w}; }
                }
                __builtin_amdgcn_sched_barrier(0);
            }
            const float nsk = -((aS0.x + aS0.y) + (aS1.x + aS1.y));
            const float nskC = -((aC0.x + aC0.y) + (aC1.x + aC1.y));
            f32x2 y0 = {0.f, 0.f}, y1 = {0.f, 0.f};
#pragma unroll
            for (int qb = 0; qb < NUB; ++qb) {
                if (NB == 2) { if (qb + 1 < NUB) RW_LD_UPD((qb + 1) & 1, qb + 1); } else RW_LD_UPD(0, qb);
                __builtin_amdgcn_sched_barrier(0);
#pragma unroll
                for (int q = 0; q < UB; ++q) {
                    const int qq = UB * qb + q;
                    const f32x4 w4 = wq[qb & (NB - 1)][q], b4 = bq[qb & (NB - 1)][q], k4 = kq[qb & (NB - 1)][q];
                    if (MODE == 0) {
                        S2[2 * qq] = S2[2 * qq] * (f32x2){w4.x, w4.y} + (f32x2){b4.x, b4.y} * nsk;
                        S2[2 * qq + 1] = S2[2 * qq + 1] * (f32x2){w4.z, w4.w} + (f32x2){b4.z, b4.w} * nsk;
                        C2[2 * qq] = C2[2 * qq] * (f32x2){w4.x, w4.y} + (f32x2){b4.x, b4.y} * nskC + (f32x2){k4.x, k4.y} * v;
                        C2[2 * qq + 1] = C2[2 * qq + 1] * (f32x2){w4.z, w4.w} + (f32x2){b4.z, b4.w} * nskC + (f32x2){k4.z, k4.w} * v;
                    } else {
                        S2[2 * qq] = S2[2 * qq] * (f32x2){w4.x, w4.y} + (f32x2){b4.x, b4.y} * nsk + (f32x2){k4.x, k4.y} * v;
                        S2[2 * qq + 1] = S2[2 * qq + 1] * (f32x2){w4.z, w4.w} + (f32x2){b4.z, b4.w} * nsk + (f32x2){k4.z, k4.w} * v;
                        const f32x4 r4 = rq[qb & (NB - 1)][q]; y0 += S2[2 * qq] * (f32x2){r4.x, r4.y}; y1 += S2[2 * qq + 1] * (f32x2){r4.z, r4.w};
                    }
                }
                __builtin_amdgcn_sched_barrier(0);
            }
#undef RW_LD_DOT
#undef RW_LD_UPD
            if (MODE == 1) ((LAS float*)st)[lane] = (y0.x + y0.y) + (y1.x + y1.y);
        }
        if (MODE == 1) {
            LDS_WAIT();
#pragma unroll
            for (int s = 0; s < SB; ++s) {
                const LAS float* st = slab + s * 512;
                const float y = st[lane], v = st[320 + lane];
                const float mean = wave_sum(y) * (1.f / 64.f), d = y - mean;
                const float var = wave_sum(d * d) * (1.f / 64.f);
                const float yn = d * frsq(var + 64e-5f) * lnw + lnb;
                MIX[(size_t)(tb + s) * D + ch] = (bf16)f2bf((yn + st[384 + lane] * v) * st[448 + lane]);
            }
        }
        LDS_WAIT();
    }
#undef RW_LOAD
    if (MODE == 0) {
#pragma unroll
        for (int q = 0; q < 16; ++q) {
            *(f32x4*)(MCM + rowoff + 4 * q) = (f32x4){S2[2 * q].x, S2[2 * q].y, S2[2 * q + 1].x, S2[2 * q + 1].y};
            *(f32x4*)(MCC + rowoff + 4 * q) = (f32x4){C2[2 * q].x, C2[2 * q].y, C2[2 * q + 1].x, C2[2 * q + 1].y};
        }
    }
}
template <int MODE> __device__ __forceinline__ void stage_rwkv_scan(const Params& P, int e, LAS unsigned char* lds) {
    int tid = threadIdx.x; asm volatile("" : "+v"(tid)); const int lane = tid & 63, wave = __builtin_amdgcn_readfirstlane(tid >> 6);
    LAS float* slab = (LAS float*)(lds + wave * 16384);
    const int gw = blockIdx.x * NWAVES + wave, ngw = gridDim.x * NWAVES;
    for (int it = gw; it < RNCH * 8; it += ngw) rwkv_item<MODE>(P, e, it >> 3, it & 7, slab, lane);
}

constexpr int P2_GS = 16, P2_NG = RNCH / P2_GS;
template <bool HAS_C, bool STORE_STEPS>
__device__ __forceinline__ void chain16(f32x4 (&acc)[4], const float* Mb, size_t mstride, float* Cb, size_t cstride, int nsteps) {
    f32x4 mc[16];
#pragma unroll
    for (int i = 0; i < 16; ++i) mc[i] = *(const f32x4*)(Mb + (size_t)i * 64);
    f32x4 qn[4];
    if (HAS_C) {
#pragma unroll
        for (int j = 0; j < 4; ++j) qn[j] = *(const f32x4*)(Cb + 4 * j);
    }
    for (int c = 0; c < nsteps; ++c) {
        float* cp = Cb + (size_t)c * cstride;
        f32x4 q[4];
        if (HAS_C) {
#pragma unroll
            for (int j = 0; j < 4; ++j) q[j] = qn[j];
            const float* cn = Cb + (size_t)(c + 1 < nsteps ? c + 1 : c) * cstride;
#pragma unroll
            for (int j = 0; j < 4; ++j) qn[j] = *(const f32x4*)(cn + 4 * j);
        }
        f32x4 mn[16];
        const float* Mn = Mb + (size_t)(c + 1 < nsteps ? c + 1 : c) * mstride;
#pragma unroll
        for (int i = 0; i < 16; ++i) mn[i] = *(const f32x4*)(Mn + (size_t)i * 64);
        if (STORE_STEPS) {
#pragma unroll
            for (int j = 0; j < 4; ++j) *(f32x4*)(cp + 4 * j) = (f32x4){acc[0][j], acc[1][j], acc[2][j], acc[3][j]};
            if (c == nsteps - 1) break;
        }
        f32x4 na[4];
#pragma unroll
        for (int n = 0; n < 4; ++n) na[n] = HAS_C ? (f32x4){q[0][n], q[1][n], q[2][n], q[3][n]} : (f32x4){0.f, 0.f, 0.f, 0.f};
#pragma unroll
        for (int n = 0; n < 4; ++n)
#pragma unroll
            for (int j = 0; j < 4; ++j) {
                const f32x4 a4 = mc[4 * j + n];
#pragma unroll
                for (int np = 0; np < 4; ++np) na[np] = __builtin_amdgcn_mfma_f32_16x16x4f32(a4[np], acc[n][j], na[np], 0, 0, 0);
            }
#pragma unroll
        for (int n = 0; n < 4; ++n) acc[n] = na[n];
#pragma unroll
        for (int i = 0; i < 16; ++i) mc[i] = mn[i];
    }
}
__device__ __forceinline__ void store_strip(const f32x4 (&acc)[4], float* dst) {
#pragma unroll
    for (int j = 0; j < 4; ++j) *(f32x4*)(dst + 4 * j) = (f32x4){acc[0][j], acc[1][j], acc[2][j], acc[3][j]};
}
__device__ __forceinline__ void stage_rwkv_pass2(const Params& P, int level) {
    int tid = threadIdx.x; asm volatile("" : "+v"(tid)); const int lane = tid & 63, wave = __builtin_amdgcn_readfirstlane(tid >> 6);
    unsigned char* ws = P.ws;
    const float* MCM = (const float*)(ws + OFF_MCM); float* MCC = (float*)(ws + OFF_MCC);
    float* MG = (float*)(ws + OFF_MG); float* CG = (float*)(ws + OFF_CG);
    const int rho = lane & 15, g4 = lane >> 4;
    const int gw = blockIdx.x * NWAVES + wave, ngw = gridDim.x * NWAVES;
    f32x4 acc[4];
    if (level == 0) {
        const bool spread = (gridDim.x == 256);
        for (int it0 = spread ? (wave < 4 ? (int)blockIdx.x : P2_NG * 64) : gw; it0 < P2_NG * 8 * 8; it0 += spread ? P2_NG * 64 : ngw) {
            int it = it0;
            if (spread) { const int x = blockIdx.x & 7, j = blockIdx.x >> 3, idx = wave * 32 + j; it = ((idx >> 3) * 8 + x) * 8 + (idx & 7); }
            const int g = it >> 6, h = (it >> 3) & 7, part = (it >> 2) & 1, s = it & 3, v = 16 * s + rho;
            const float* Mb = MCM + ((size_t)(g * P2_GS) * 8 + h) * 4096 + (size_t)(16 * g4) * 64 + 4 * rho;
            float* Cb = MCC + ((size_t)(g * P2_GS) * 8 + h) * 4096 + (size_t)v * 64 + 16 * g4;
            if (part == 0) {
#pragma unroll
                for (int n = 0; n < 4; ++n)
#pragma unroll
                    for (int j = 0; j < 4; ++j) acc[n][j] = (v == 16 * g4 + 4 * j + n) ? 1.f : 0.f;
                chain16<false, false>(acc, Mb, 32768, Cb, 32768, P2_GS);
                store_strip(acc, MG + ((size_t)g * 8 + h) * 4096 + (size_t)v * 64 + 16 * g4);
            } else {
#pragma unroll
                for (int n = 0; n < 4; ++n) acc[n] = (f32x4){0.f, 0.f, 0.f, 0.f};
                chain16<true, false>(acc, Mb, 32768, Cb, 32768, P2_GS);
                store_strip(acc, CG + ((size_t)g * 8 + h) * 4096 + (size_t)v * 64 + 16 * g4);
            }
        }
    } else if (level == 1) {
        if (wave == 0 && blockIdx.x < 32) {
            const int h = blockIdx.x >> 2, s = blockIdx.x & 3, v = 16 * s + rho;
#pragma unroll
            for (int n = 0; n < 4; ++n) acc[n] = (f32x4){0.f, 0.f, 0.f, 0.f};
            chain16<true, true>(acc, MG + (size_t)h * 4096 + (size_t)(16 * g4) * 64 + 4 * rho, 32768, CG + (size_t)h * 4096 + (size_t)v * 64 + 16 * g4, 32768, P2_NG);
        }
    } else {
        const bool spread = (gridDim.x == 256);
        for (int it0 = spread ? (wave < 2 ? (int)blockIdx.x : P2_NG * 32) : gw; it0 < P2_NG * 8 * 4; it0 += spread ? P2_NG * 32 : ngw) {
            int it = it0;
            if (spread) { const int x = blockIdx.x & 7, j = blockIdx.x >> 3, idx = wave * 32 + j; it = ((idx >> 2) * 8 + x) * 4 + (idx & 3); }
            const int g = it >> 5, h = (it >> 2) & 7, s = it & 3, v = 16 * s + rho;
            const float* sg = CG + ((size_t)g * 8 + h) * 4096 + (size_t)v * 64 + 16 * g4;
            f32x4 q[4];
#pragma unroll
            for (int j = 0; j < 4; ++j) q[j] = *(const f32x4*)(sg + 4 * j);
#pragma unroll
            for (int n = 0; n < 4; ++n) acc[n] = (f32x4){q[0][n], q[1][n], q[2][n], q[3][n]};
            const float* Mb = MCM + ((size_t)(g * P2_GS) * 8 + h) * 4096 + (size_t)(16 * g4) * 64 + 4 * rho;
            float* Cb = MCC + ((size_t)(g * P2_GS) * 8 + h) * 4096 + (size_t)v * 64 + 16 * g4;
            chain16<true, true>(acc, Mb, 32768, Cb, 32768, P2_GS);
        }
    }
}

__device__ __forceinline__ void stage_postB(const Params& P, int e) {
    unsigned char* ws = P.ws;
    const bf16* PB = (const bf16*)(ws + OFF_PB); bf16* MIX = (bf16*)(ws + OFF_MIXE);
    int ch = threadIdx.x; asm volatile("" : "+v"(ch));
    const float* cw = P.in[I_BCONV] + (size_t)e * 3 * 512;
    const float w0 = cw[ch], w1 = cw[512 + ch], w2 = cw[1024 + ch];
    for (int tile = blockIdx.x; tile < T / 64; tile += gridDim.x) {
        const int t0 = tile * 64;
        float x0 = t0 >= 2 ? bf2f(PB[(size_t)(t0 - 2) * DINO + 512 + ch]) * bf2f(PB[(size_t)(t0 - 2) * DINO + 1024 + ch]) : 0.f;
        float x1 = t0 >= 1 ? bf2f(PB[(size_t)(t0 - 1) * DINO + 512 + ch]) * bf2f(PB[(size_t)(t0 - 1) * DINO + 1024 + ch]) : 0.f;
#pragma unroll 1
        for (int tb = t0; tb < t0 + 64; tb += 16) {
            bf16 rb[16], rc[16], rh[16];
#pragma unroll
            for (int i = 0; i < 16; ++i) { const bf16* row = PB + (size_t)(tb + i) * DINO; rb[i] = row[ch]; rc[i] = row[512 + ch]; rh[i] = row[1024 + ch]; }
            __builtin_amdgcn_sched_barrier(0);
            float bb[16], cc[16], hv[16];
#pragma unroll
            for (int i = 0; i < 16; ++i) { bb[i] = bf2f(rb[i]); cc[i] = bf2f(rc[i]); hv[i] = bf2f(rh[i]); }
#pragma unroll
            for (int i = 0; i < 16; ++i) { const float x2 = cc[i] * hv[i];
                MIX[(size_t)(tb + i) * D + 512 + ch] = (bf16)f2bf(bb[i] * (w0 * x0 + w1 * x1 + w2 * x2)); x0 = x1; x1 = x2; }
        }
    }
}

__device__ __forceinline__ void stage_lruE(const Params& P, int o) {
    unsigned char* ws = P.ws;
    const bf16* PO = (const bf16*)(ws + OFF_PO);
    bf16* UC = (bf16*)(ws + OFF_UC); bf16* PD = (bf16*)(ws + OFF_PD);
    int tid = threadIdx.x; asm volatile("" : "+v"(tid));
    const size_t gt = (size_t)blockIdx.x * NTHREADS + tid, ngt = (size_t)gridDim.x * NTHREADS;
    stage_images(P, 1, o);
    const float* cw = P.in[I_CCONVW] + (size_t)o * 4 * 512;
    for (size_t it = gt; it < (size_t)(T / 16) * 1024; it += ngt) {
        const int tile = (int)(it >> 10), c = (int)(it & 1023), t0 = tile * 16;
        if (c < 512) {
            const float cw0 = cw[c], cw1 = cw[512 + c], cw2 = cw[1024 + c], cw3 = cw[1536 + c], cb = P.in[I_CCONVB][o * 512 + c];
            float u[19]; bf16 raw[19];
#pragma unroll
            for (int i = 0; i < 19; ++i) { const int tg = t0 - 3 + i; raw[i] = PO[(size_t)(tg > 0 ? tg : 0) * DINO + 512 + c]; }
            __builtin_amdgcn_sched_barrier(0);
#pragma unroll
            for (int i = 0; i < 19; ++i) { const int tg = t0 - 3 + i; u[i] = tg >= 0 ? bf2f(raw[i]) : 0.f; }
#pragma unroll
            for (int i = 0; i < 16; ++i) UC[(size_t)(t0 + i) * 512 + c] = (bf16)f2bf(cw0 * u[i] + cw1 * u[i + 1] + cw2 * u[i + 2] + cw3 * u[i + 3] + cb);
        } else {
            const int cc = c - 512, gsel = cc >> 7, win = 2 << gsel;
            float xs[32]; bf16 raw[32];
#pragma unroll
            for (int i = 0; i < 32; ++i) { const int tg = t0 - 16 + i; raw[i] = PO[(size_t)(tg > 0 ? tg : 0) * DINO + 1024 + cc]; }
            __builtin_amdgcn_sched_barrier(0);
#pragma unroll
            for (int i = 0; i < 32; ++i) { const int tg = t0 - 16 + i; xs[i] = tg >= 0 ? bf2f(raw[i]) : 0.f; }
            float ps[32]; ps[0] = xs[0];
#pragma unroll
            for (int i = 1; i < 32; ++i) ps[i] = ps[i - 1] + xs[i];
#pragma unroll
            for (int i = 0; i < 16; ++i) {
                const int j = 16 + i, tg = t0 + i;
                const float s2 = ps[j] - ps[j - 2], s4 = ps[j] - ps[j - 4], s8 = ps[j] - ps[j - 8], s16 = ps[j] - ps[j - 16];
                const float sw = gsel == 0 ? s2 : gsel == 1 ? s4 : gsel == 2 ? s8 : s16;
                const int n = tg + 1 < win ? tg + 1 : win;
                PD[(size_t)tg * 512 + cc] = (bf16)f2bf(sw * frcp((float)n) - xs[j]);
            }
        }
    }
}
struct EpiGates {
    static constexpr bool PERM = true, AFTER_DRAIN = false;
    unsigned char* wsb; const float* ba; const float* bx; const float* lam;
    __device__ __forceinline__ void operator()(const f32x4 (&acc)[2][2][4][2], const pg8::Unit& u, int wr, int wc, int fr, int fq) const {
        const int row0 = u.pm * 256 + wr * 64 + fr, kind = u.pn >> 1, colb = (u.pn & 1) * 256 + wc * 32 + 8 * fq;
        float* OUT = (float*)(wsb + (kind == 0 ? OFF_LA : OFF_LBX));
        const float* bias = kind == 0 ? ba : bx;
#pragma unroll
        for (int bj = 0; bj < 2; ++bj) {
            const int col = colb + bj * 128;
            const f32x4 b0 = *(const f32x4*)(bias + col), b1 = *(const f32x4*)(bias + col + 4);
            f32x4 l0 = {1.f, 1.f, 1.f, 1.f}, l1 = {1.f, 1.f, 1.f, 1.f};
            if (kind == 0) {
                const f32x4 m0 = *(const f32x4*)(lam + col), m1 = *(const f32x4*)(lam + col + 4);
#pragma unroll
                for (int i = 0; i < 4; ++i) { l0[i] = -8.0f * (fmaxf(-m0[i], 0.f) + log1pf(expf(-fabsf(m0[i])))); l1[i] = -8.0f * (fmaxf(-m1[i], 0.f) + log1pf(expf(-fabsf(m1[i])))); }
            }
#pragma unroll
            for (int ai = 0; ai < 2; ++ai)
#pragma unroll
                for (int m = 0; m < 4; ++m) {
                    const size_t off = (size_t)(row0 + ai * 128 + m * 16) * 512 + col;
                    f32x4 v0 = acc[ai][bj][m][0] + b0, v1 = acc[ai][bj][m][1] + b1;
#pragma unroll
                    for (int i = 0; i < 4; ++i) { v0[i] = sigm(v0[i]) * l0[i]; v1[i] = sigm(v1[i]) * l1[i]; }
                    *(f32x4*)(OUT + off) = v0; *(f32x4*)(OUT + off + 4) = v1;
                }
        }
    }
};
struct EpiPool {
    static constexpr bool PERM = true, AFTER_DRAIN = false;
    bf16* MIX; const float* scale;
    __device__ __forceinline__ void operator()(const f32x4 (&acc)[2][2][4][2], const pg8::Unit& u, int wr, int wc, int fr, int fq) const {
        const int row0 = u.pm * 256 + wr * 64 + fr, colb = u.pn * 256 + wc * 32 + 8 * fq;
#pragma unroll
        for (int bj = 0; bj < 2; ++bj) {
            const int col = colb + bj * 128;
            const f32x4 s0 = *(const f32x4*)(scale + col), s1 = *(const f32x4*)(scale + col + 4);
#pragma unroll
            for (int ai = 0; ai < 2; ++ai)
#pragma unroll
                for (int m = 0; m < 4; ++m) {
                    const f32x4 v0 = acc[ai][bj][m][0] * s0, v1 = acc[ai][bj][m][1] * s1;
                    u32x4 w; w.x = pg8::cvt_pk_bf16(v0[0], v0[1]); w.y = pg8::cvt_pk_bf16(v0[2], v0[3]); w.z = pg8::cvt_pk_bf16(v1[0], v1[1]); w.w = pg8::cvt_pk_bf16(v1[2], v1[3]);
                    *(u32x4*)(MIX + (size_t)(row0 + ai * 128 + m * 16) * D + 512 + col) = w;
                }
        }
    }
};
__device__ __forceinline__ void stage_lruA(const Params& P) {
    unsigned char* ws = P.ws;
    float* LA = (float*)(ws + OFF_LA); float* LBX = (float*)(ws + OFF_LBX); float* CHA = (float*)(ws + OFF_CHA); float* CHB = (float*)(ws + OFF_CHB);
    const bf16* UC = (const bf16*)(ws + OFF_UC);
    int tid = threadIdx.x; asm volatile("" : "+v"(tid)); const int lane = tid & 63, wave = __builtin_amdgcn_readfirstlane(tid >> 6);
    const int gw = blockIdx.x * NWAVES + wave, ngw = gridDim.x * NWAVES;
    for (int it = gw; it < NCH * 8; it += ngw) {
        const int c = it >> 3, h = it & 7, ch = h * 64 + lane;
        float hh = 0.f, ap = 1.f;
#pragma unroll 1
        for (int tb = c * LCH; tb < (c + 1) * LCH; tb += 16) {
            float la[16], ig[16], uc[16];
#pragma unroll
            for (int i = 0; i < 16; ++i) { la[i] = LA[(size_t)(tb + i) * 512 + ch]; ig[i] = LBX[(size_t)(tb + i) * 512 + ch]; uc[i] = bf2f(UC[(size_t)(tb + i) * 512 + ch]); }
#pragma unroll
            for (int i = 0; i < 16; ++i) {
                const float a = __expf(la[i]), x2 = 2.f * la[i];
                const float em = x2 > -0.1f ? -x2 * (1.f + x2 * (0.5f + x2 * (0.16666667f + x2 * 0.041666668f))) : 1.f - __expf(x2);
                const float mult = (tb + i) == 0 ? 1.f : __builtin_amdgcn_sqrtf(em);
                const float bxv = mult * ig[i] * uc[i];
                hh = a * hh + bxv; ap *= a;
                LA[(size_t)(tb + i) * 512 + ch] = a; LBX[(size_t)(tb + i) * 512 + ch] = bxv;
            }
        }
        CHA[(size_t)c * 512 + ch] = ap; CHB[(size_t)c * 512 + ch] = hh;
    }
}
__device__ __forceinline__ void stage_lru2(const Params& P) {
    if (blockIdx.x >= 8) return;
    int tid = threadIdx.x; asm volatile("" : "+v"(tid)); if (tid >= 64) return;
    unsigned char* ws = P.ws;
    const float* CHA = (const float*)(ws + OFF_CHA); const float* CHB = (const float*)(ws + OFF_CHB); float* CAR = (float*)(ws + OFF_CAR);
    const int ch = blockIdx.x * 64 + tid;
    float hcar = 0.f;
#pragma unroll 8
    for (int c = 0; c < NCH; ++c) { CAR[(size_t)c * 512 + ch] = hcar; hcar = CHA[(size_t)c * 512 + ch] * hcar + CHB[(size_t)c * 512 + ch]; }
}
__device__ __forceinline__ float gelu_tanh(float x) { const float u = 0.7978845608028654f * (x + 0.044715f * x * x * x); return 0.5f * x * (1.f + tanh_fast(u)); }
__device__ __forceinline__ void stage_lru3(const Params& P) {
    unsigned char* ws = P.ws;
    const bf16* PO = (const bf16*)(ws + OFF_PO); bf16* MIX = (bf16*)(ws + OFF_MIXO);
    int tid = threadIdx.x; asm volatile("" : "+v"(tid)); const int lane = tid & 63, wave = __builtin_amdgcn_readfirstlane(tid >> 6);
    {
        const float* LA = (const float*)(ws + OFF_LA); const float* LBX = (const float*)(ws + OFF_LBX); const float* CAR = (const float*)(ws + OFF_CAR);
        const int gw = blockIdx.x * NWAVES + wave, ngw = gridDim.x * NWAVES;
        for (int it = gw; it < NCH * 8; it += ngw) {
            const int c = it >> 3, h = it & 7, ch = h * 64 + lane;
            const float* CHA = (const float*)(ws + OFF_CHA); const float* CHB = (const float*)(ws + OFF_CHB);
            float hh = 0.f;
#pragma unroll 1
            for (int cb = 0; cb < c; cb += 16) {
                float ca[16], cbv[16];
#pragma unroll
                for (int i = 0; i < 16; ++i) { const int cc = cb + i < c ? cb + i : c - 1; ca[i] = CHA[(size_t)cc * 512 + ch]; cbv[i] = CHB[(size_t)cc * 512 + ch]; }
#pragma unroll
                for (int i = 0; i < 16; ++i) if (cb + i < c) hh = ca[i] * hh + cbv[i];
            }
#pragma unroll 1
            for (int tb = c * LCH; tb < (c + 1) * LCH; tb += 16) {
                float a_[16], b_[16], g_[16];
#pragma unroll
                for (int i = 0; i < 16; ++i) { a_[i] = LA[(size_t)(tb + i) * 512 + ch]; b_[i] = LBX[(size_t)(tb + i) * 512 + ch]; g_[i] = bf2f(PO[(size_t)(tb + i) * DINO + ch]); }
#pragma unroll
                for (int i = 0; i < 16; ++i) { hh = a_[i] * hh + b_[i]; MIX[(size_t)(tb + i) * D + ch] = (bf16)f2bf(gelu_tanh(g_[i]) * hh); }
            }
        }
    }
}

constexpr int OPS_PER_LAYER = 19;
constexpr int N_PHASES = DEPTH * OPS_PER_LAYER + 1;
#ifndef MK_PER_PHASE_LAUNCH
#define MK_PER_PHASE_LAUNCH 0
#endif
__host__ __device__ inline bool phase_is_nop(int ph) {
    if (ph >= DEPTH * OPS_PER_LAYER) return false;
    const int layer = ph / OPS_PER_LAYER, op = ph % OPS_PER_LAYER;
    return ((layer & 1) && ((op >= 10 && op <= 14) || op == 8)) || (layer == 0 && op == 7);
}

__device__ __forceinline__ void ffn_weights(const Params& P, int layer, int which, LAS float* scr, int gw, int ngw, int lane) {
    const size_t fo = ((size_t)layer * 2 + which) * (size_t)D * FF;
    bf16* Wgu = (bf16*)(P.ws + OFF_W); bf16* Wdt = (bf16*)(P.ws + OFF_WB);
    conv_matrix(P.in[I_WG] + fo, D, FF, Wgu, 1, scr, gw, ngw, lane);
    conv_matrix(P.in[I_WU] + fo, D, FF, Wgu, 2, scr, gw, ngw, lane);
    conv_matrix(P.in[I_WD] + fo, FF, D, Wdt, 0, scr, gw, ngw, lane);
}

#define XB_TMO      128
#define XB_XCNT(j)  (256  + 64 * (j))
#define XB_XSUB(j)  (1280 + 64 * (j))
#define XB_XGEN(j)  (2304 + 64 * (j))
#define XB_TOP      3328
#define XB_TOPGEN   3392
#define XCD_BAR_WORDS 3456
#define XB_SPIN_CAP (1u << 18)

__device__ __forceinline__ unsigned xb_ld(unsigned* p)              { return __hip_atomic_load(p, __ATOMIC_RELAXED, __HIP_MEMORY_SCOPE_AGENT); }
__device__ __forceinline__ unsigned xb_add(unsigned* p, unsigned v) { return __hip_atomic_fetch_add(p, v, __ATOMIC_RELAXED, __HIP_MEMORY_SCOPE_AGENT); }
__device__ __forceinline__ unsigned xb_xcc_id() { return (unsigned)__builtin_amdgcn_s_getreg((3 << 11) | 20) & 0xFu; }
#define XB_SPIN(cond, bar) do { unsigned _sp = 0; while (cond) { __builtin_amdgcn_s_sleep(1); \
    if ((++_sp & 255u) == 0u) { if (xb_ld(&(bar)[XB_TMO])) break; if (_sp > XB_SPIN_CAP) { atomicAdd(&(bar)[XB_TMO], 1u); break; } } } } while (0)

struct XcdBarrier {
    unsigned* bar; unsigned x;
    volatile LAS unsigned* st;
};

__device__ __forceinline__ XcdBarrier xcd_barrier_post(unsigned* bar, volatile LAS unsigned* st) {
    XcdBarrier b; b.bar = bar; b.x = xb_xcc_id(); b.st = st;
    if (threadIdx.x == 0) (void)xb_add(&bar[XB_XCNT(b.x)], 1u);
    return b;
}
__device__ __forceinline__ void xcd_barrier_complete(unsigned* bar, unsigned x, unsigned& nloc, unsigned& nx) {
    const unsigned G = gridDim.x * gridDim.y * gridDim.z;
    unsigned sum, cnt, mine, sp = 0u;
    for (;;) {
        sum = 0u; cnt = 0u; mine = 0u;
#pragma unroll
        for (unsigned j = 0; j < 16; ++j) { const unsigned c = xb_ld(&bar[XB_XCNT(j)]); sum += c; cnt += (c > 0u) ? 1u : 0u; mine = (j == x) ? c : mine; }
        if (sum == G) break;
        __builtin_amdgcn_s_sleep(1);
        if ((++sp & 255u) == 0u) { if (xb_ld(&bar[XB_TMO])) break; if (sp > XB_SPIN_CAP) { atomicAdd(&bar[XB_TMO], 1u); break; } }
    }
    nloc = mine > 0u ? mine : 1u; nx = cnt > 0u ? cnt : 1u;
}

__device__ __forceinline__ void xcd_barrier(const XcdBarrier& b) {
    asm volatile("s_waitcnt vmcnt(0)" ::: "memory");
    __syncthreads();
    if (threadIdx.x == 0) {
        unsigned* bar = b.bar;
        __builtin_amdgcn_s_waitcnt(0);
        unsigned nloc = b.st[0], nx = b.st[1];
        if (nloc == 0u) { xcd_barrier_complete(bar, b.x, nloc, nx); b.st[0] = nloc; b.st[1] = nx; }
        const unsigned old = xb_add(&bar[XB_XSUB(b.x)], 1u);
        const unsigned gen = old / nloc;
        if (old + 1u == (gen + 1u) * nloc) {
            __builtin_amdgcn_fence(__ATOMIC_RELEASE, "agent");
            asm volatile("s_waitcnt vmcnt(0)" ::: "memory");
            const unsigned og = xb_add(&bar[XB_TOP], 1u);
            const unsigned tg = og / nx;
            if (og + 1u == (tg + 1u) * nx) xb_add(&bar[XB_TOPGEN], 1u);
            else XB_SPIN(xb_ld(&bar[XB_TOPGEN]) == tg, bar);
            __builtin_amdgcn_fence(__ATOMIC_ACQUIRE, "agent");
            xb_add(&bar[XB_XGEN(b.x)], 1u);
            asm volatile("s_waitcnt vmcnt(0)" ::: "memory");
        } else {
            XB_SPIN(xb_ld(&bar[XB_XGEN(b.x)]) == gen, bar);
            __builtin_amdgcn_fence(__ATOMIC_ACQUIRE, "agent");
            asm volatile("s_waitcnt vmcnt(0)" ::: "memory");
        }
    }
    __syncthreads();
}


static_assert(XCD_BAR_WORDS * 4 <= SZ_CTL, "ctl");
#ifndef PROBE_MASK
#define PROBE_MASK 0
#endif
#ifndef PROBE_PAR
#define PROBE_PAR -1
#endif
#ifndef PROBE_SYNCS
#define PROBE_SYNCS 0
#endif
__device__ __forceinline__ void run_phase(const Params& P, int ph, LAS unsigned char* lds, bool junk) {
    unsigned char* ws = P.ws;
    int tid = threadIdx.x; asm volatile("" : "+v"(tid));
    const int lane = tid & 63, wave = __builtin_amdgcn_readfirstlane(tid >> 6);
    const int gw = blockIdx.x * NWAVES + wave, ngw = gridDim.x * NWAVES;
    LAS float* scr = (LAS float*)(lds + wave * 16384);
    float* X = (float*)(ws + OFF_X); bf16* H = (bf16*)(ws + OFF_H); bf16* ACT = (bf16*)(ws + OFF_ACT);
    bf16* W0 = (bf16*)(ws + OFF_W); bf16* W1 = (bf16*)(ws + OFF_WB);
    if (ph == DEPTH * OPS_PER_LAYER) { rmsnorm_rows(X, P.in[I_FINALG], nullptr, P.out, gw, ngw, lane); return; }
    const int layer = ph / OPS_PER_LAYER, op = ph % OPS_PER_LAYER, odd = layer & 1, idx = layer >> 1;
    const float* Xin = (layer == 0) ? P.in[I_X] : X;
    switch (op) {
    case 0: ffn_weights(P, layer, 0, scr, gw, ngw, lane); rmsnorm_rows(Xin, P.in[I_NORMG] + ((size_t)layer * 3 + 0) * D, H, nullptr, gw, ngw, lane); break;
    case 1: case 17: run_gemm(lds, H, W0, T, 2 * FF, D, EpiSwiglu{ACT}); break;
    case 2: run_gemm(lds, ACT, W1, T, D, FF, EpiResid{Xin, junk ? (float*)(ws + OFF_U + 100000000) : X, 0.5f}); break;
    case 18: run_gemm(lds, ACT, W1, T, D, FF, EpiResid{X, junk ? (float*)(ws + OFF_U + 100000000) : X, 0.5f}); break;
    case 3:
        if (!odd) { conv_matrix(P.in[I_EWIN] + (size_t)idx * D * DINE, D, DINE, W0, 0, scr, gw, ngw, lane);
                    conv_matrix(P.in[I_EWOUT] + (size_t)idx * D * D, D, D, W1, 0, scr, gw, ngw, lane); }
        else      { conv_matrix(P.in[I_OWIN] + (size_t)idx * D * DINO, D, DINO, W0, 0, scr, gw, ngw, lane);
                    conv_matrix(P.in[I_OWOUT] + (size_t)idx * D * D, D, D, W1, 0, scr, gw, ngw, lane); }
        rmsnorm_rows(X, P.in[I_NORMG] + ((size_t)layer * 3 + 1) * D, H, nullptr, gw, ngw, lane); break;
    case 4:
        if (!odd) run_gemm(lds, H, W0, T, DINA, D, EpiStoreBf16{(bf16*)(ws + OFF_PA), DINA});
        else      run_gemm(lds, H, W0, T, DINO, D, EpiStoreBf16{(bf16*)(ws + OFF_PO), DINO});
        break;
    case 5: if (!odd) stage_prepE(P, idx); else stage_lruE(P, idx); break;
    case 6:
        if (!odd) {
            run_gemm(lds, (const bf16*)(ws + OFF_LIN), (const bf16*)(ws + OFF_WCAT), T, 1536, 256,
                     EpiLora{ws, P.in[I_AW0] + idx * 512, P.in[I_AA0] + idx * 512});
            if (idx > 0) run_gemm(lds, (const bf16*)(ws + OFF_V16), (const bf16*)(ws + OFF_WVDN), T, 256, 512, EpiStoreBf16{(bf16*)(ws + OFF_LOW), 256});
        } else {
            run_gemm(lds, (const bf16*)(ws + OFF_UC), (const bf16*)(ws + OFF_WG), T, 1024, 512, EpiGates{ws, P.in[I_CBA] + idx * 512, P.in[I_CBX] + idx * 512, P.in[I_CLAM] + idx * 512});
            run_gemm(lds, (const bf16*)(ws + OFF_PD), (const bf16*)(ws + OFF_WP), T, 512, 512, EpiPool{(bf16*)(ws + OFF_MIXO), P.in[I_DSCALE] + idx * 512});
        }
        break;
    case 7:
        if (!odd) run_gemm(lds, (const bf16*)(ws + OFF_LOW), (const bf16*)(ws + OFF_WVUP), T, 512, 256, EpiVres{(bf16*)(ws + OFF_V16), (const bf16*)(ws + OFF_VF), P.in[I_AV0] + (idx - 1) * 512});
        else stage_lruA(P);
        break;
    case 8: if (!odd) stage_rwkv_scan<0>(P, idx, lds); break;
    case 9: if (!odd) stage_rwkv_pass2(P, 0); else stage_lru3(P); break;
    case 10: stage_rwkv_pass2(P, 1); break;
    case 11: stage_rwkv_pass2(P, 2); break;
    case 12: stage_rwkv_scan<1>(P, idx, lds); break;
    case 13: run_gemm(lds, H, W0 + (size_t)DINA * D, T, DINO, D, EpiStoreBf16{(bf16*)(ws + OFF_PB), DINO}); break;
    case 14: stage_postB(P, idx); break;
    case 15: run_gemm(lds, (const bf16*)(ws + (odd ? OFF_MIXO : OFF_MIXE)), W1, T, D, D, EpiResid{X, junk ? (float*)(ws + OFF_U) : X, 1.0f}); break;
    case 16: ffn_weights(P, layer, 1, scr, gw, ngw, lane); rmsnorm_rows(X, P.in[I_NORMG] + ((size_t)layer * 3 + 2) * D, H, nullptr, gw, ngw, lane); break;
    default: break;
    }
}

__global__ void __launch_bounds__(NTHREADS, 2) mega_fwd(Params P) {
    extern __shared__ __attribute__((aligned(16))) unsigned char lds_raw[];
    LAS unsigned char* lds = (LAS unsigned char*)lds_raw;
    cg::grid_group grid = cg::this_grid();
    bool first = true;
    const int ph_lo = P.ph_lo, ph_hi = P.ph_hi;
    if (ph_lo < 0) grid.sync();
    volatile LAS unsigned* bst = (volatile LAS unsigned*)(lds + 131072 + 64);
    if (threadIdx.x < 2) bst[threadIdx.x] = 0u;
    __syncthreads();
    (void)xcd_barrier_post((unsigned*)(P.ws + OFF_CTL), bst);
#define GRID_BAR() do { const __attribute__((address_space(4))) Params* Pb = (const __attribute__((address_space(4))) Params*)__builtin_amdgcn_kernarg_segment_ptr(); asm volatile("" : "+s"(Pb)); \
        XcdBarrier bar_; bar_.bar = (unsigned*)(Pb->ws + OFF_CTL); bar_.x = xb_xcc_id(); bar_.st = (volatile LAS unsigned*)(lds + 131072 + 64); xcd_barrier(bar_); } while (0)
    for (int i = 0; i < PROBE_SYNCS; ++i) GRID_BAR();
    for (int ph = ph_lo; ph < ph_hi; ++ph) {
        if (phase_is_nop(ph)) continue;
        int nrep = 1;
        if (PROBE_MASK != 0 && ph < DEPTH * OPS_PER_LAYER) {
            const int layer = ph / OPS_PER_LAYER, op = ph % OPS_PER_LAYER;
            if (((PROBE_MASK >> op) & 1) && (PROBE_PAR < 0 || (layer & 1) == PROBE_PAR) && !((op == 7 || op == 10 || op == 11) && !(layer & 1)) && !((op == 7) && (layer & 1))) nrep = 2;
        }
        for (int rep = 0; rep < nrep; ++rep) {
            if (!first) GRID_BAR();
            first = false;
            const __attribute__((address_space(4))) Params* Pk = (const __attribute__((address_space(4))) Params*)__builtin_amdgcn_kernarg_segment_ptr();
            asm volatile("" : "+s"(Pk));
            run_phase(*(const Params*)Pk, ph, lds, rep > 0);
            __syncthreads();
        }
    }
}

extern "C" void kernel_launch(void* const* d_in, const int* in_sizes, int n_in, void* d_out, int out_size, void* d_ws, size_t ws_size, hipStream_t stream) {
    static int grid = 0;
    if (grid == 0) {
        if (n_in != N_IN || out_size != T * D || ws_size < WS_END) { fprintf(stderr, "kernel_launch: unexpected shapes (n_in %d, out %d, ws %zu, need %zu)\n", n_in, out_size, ws_size, (size_t)WS_END); grid = -1; return; }
        int dev = 0, cus = 0, per_cu = 0;
        hipGetDevice(&dev); hipDeviceGetAttribute(&cus, hipDeviceAttributeMultiprocessorCount, dev);
        if (hipFuncSetAttribute((const void*)mega_fwd, hipFuncAttributeMaxDynamicSharedMemorySize, LDS_BYTES) != hipSuccess) { fprintf(stderr, "kernel_launch: hipFuncSetAttribute failed\n"); grid = -1; return; }
        hipOccupancyMaxActiveBlocksPerMultiprocessor(&per_cu, (const void*)mega_fwd, NTHREADS, LDS_BYTES);
        if (per_cu < 1) per_cu = 1;
        grid = cus * 1;
    }
    if (grid <= 0) return;
    Params P{};
    for (int i = 0; i < N_IN; ++i) P.in[i] = (const float*)d_in[i];
    P.out = (float*)d_out; P.ws = (unsigned char*)d_ws;
#if MK_PER_PHASE_LAUNCH
    for (int ph = 0; ph < N_PHASES; ++ph) {
        if (phase_is_nop(ph)) continue;
        P.ph_lo = ph; P.ph_hi = ph + 1;
        void* args[] = {&P};
        hipError_t e = hipLaunchCooperativeKernel((const void*)mega_fwd, dim3(grid), dim3(NTHREADS), args, LDS_BYTES, stream);
        if (e != hipSuccess) { fprintf(stderr, "launch %d failed: %s\n", ph, hipGetErrorString(e)); break; }
    }
#else
    P.ph_lo = 0; P.ph_hi = N_PHASES;
    if (hipMemsetAsync((char*)d_ws + OFF_CTL, 0, SZ_CTL, stream) != hipSuccess) { fprintf(stderr, "memset failed\n"); return; }
    void* args[] = {&P};
    hipError_t e = hipLaunchCooperativeKernel((const void*)mega_fwd, dim3(grid), dim3(NTHREADS), args, LDS_BYTES, stream);
    if (e != hipSuccess) fprintf(stderr, "cooperative launch failed: %s (grid %d)\n", hipGetErrorString(e), grid);
#endif
}
```

```cpp
#include <hip/hip_runtime.h>
#include <hip/hip_cooperative_groups.h>
#include <cstdio>
#include <cstdint>
namespace cg = cooperative_groups;
namespace pg8 {
#define PG8_LAS __attribute__((address_space(3)))
typedef unsigned short bf16_t;
typedef short bf16x8 __attribute__((ext_vector_type(8)));
typedef float f32x4 __attribute__((ext_vector_type(4)));
typedef unsigned u32x4 __attribute__((ext_vector_type(4)));
constexpr int BM = 256, BK = 64, HALF = 128, HTB = HALF * BK * 2  , STAGE_BYTES = 8 * HTB, NXCD = 8, WGM = 4;

__host__ __device__ __forceinline__ int lds_byte(int r, int c) { const int st = (r >> 4) * 2 + (c >> 5), rr = r & 15, cc = c & 31, ob = rr * 64 + cc * 2; return st * 1024 + (ob ^ (((ob >> 9) & 1) << 5)); }
__host__ __device__ __forceinline__ void stage_rc(int b, int& R, int& C) { const int st = b / 1024, sb = b % 1024, swz = sb ^ (((sb >> 9) & 1) << 5); R = (st >> 1) * 16 + swz / 64; C = (st & 1) * 32 + (swz % 64) / 2; }
__host__ __device__ __forceinline__ int perm32(int rho) { const int n = rho >> 4, i = rho & 15; return 8 * (i >> 2) + 4 * n + (i & 3); }

struct Unit { int pm, pn; };
struct Gemm { const bf16_t* A; const bf16_t* Bt; int M, N, K; };

struct StaticOrder {
    int nM, nN, nwg, G, c;
    __host__ __device__ void init(int M, int N, int G_, int c_) { nM = M / BM; nN = N / BM; nwg = nM * nN; G = G_; c = c_; }
    __host__ __device__ bool next(int i, Unit& u) const {
        const long L = (long)i * G + c; if (L >= nwg) return false;
        int wgid = (int)L; { const int q = nwg / NXCD, r = nwg % NXCD, xcd = wgid % NXCD, off = wgid / NXCD; wgid = (xcd < r ? xcd * (q + 1) : r * (q + 1) + (xcd - r) * q) + off; }
        const int nig = WGM * nN, gid = wgid / nig, fm = gid * WGM, gsz = (nM - fm) < WGM ? (nM - fm) : WGM;
        u.pm = fm + ((wgid % nig) % gsz); u.pn = (wgid % nig) / gsz; return true;
    }
    __device__ __forceinline__ void a_ready(const Unit&) const {}
    __device__ __forceinline__ void done(const Unit&) const {}
};

__device__ __forceinline__ unsigned cvt_pk_bf16(float lo, float hi) { unsigned r; asm volatile("v_cvt_pk_bf16_f32 %0, %1, %2" : "=v"(r) : "v"(lo), "v"(hi)); return r; }
typedef float f32x2 __attribute__((ext_vector_type(2)));

template <class Epi, class Sched, bool ALIGN_EPI = false, bool SP2 = false>
__device__ __forceinline__ void gemm_phase(PG8_LAS unsigned char* lds, const Gemm g, const Sched& S, const Epi& E) {
    int tid = threadIdx.x; asm volatile("" : "+v"(tid)); const int wid = __builtin_amdgcn_readfirstlane(tid >> 6), lane = tid & 63, wr = wid >> 2, wc = wid & 3, fr = lane & 15, fq = lane >> 4;
    const int K = g.K, nt = K / BK;
    unsigned voffA[2], voffB[2];
#pragma unroll
    for (int i = 0; i < 2; ++i) { int R, C; stage_rc(tid * 16 + i * 8192, R, C); const int Rb = Epi::PERM ? ((R & ~31) + perm32(R & 31)) : R;
        voffA[i] = (unsigned)(R * K + C) * 2u; voffB[i] = (unsigned)(Rb * K + C) * 2u; }
    const size_t kstep = (size_t)(BK * 2);
    const size_t hstep = (size_t)HALF * K * 2;
    const size_t tstep = 2 * hstep;
    const unsigned ldsw = (unsigned)wid * 1024u;
    const int aoff = lds_byte(wr * 64 + fr, fq * 8), boff = lds_byte(wc * 32 + fr, fq * 8);
#define PG8_SA(b, h) (((b) * 2 + (h)) * HTB)
#define PG8_SB(b, h) ((4 + (b) * 2 + (h)) * HTB)
#define PG8_STAGE(bufoff, gbase, voff) do { _Pragma("unroll") for (int _i = 0; _i < 2; ++_i) \
        __builtin_amdgcn_global_load_lds((const unsigned*)((const char*)(gbase) + (voff)[_i]), (PG8_LAS unsigned*)(lds + (bufoff) + ldsw + _i * 8192), 16, 0, 0); } while (0)
#define PG8_LDA(dst, b, h) do { _Pragma("unroll") for (int m = 0; m < 4; ++m) _Pragma("unroll") for (int k = 0; k < 2; ++k) dst[m][k] = *(const PG8_LAS bf16x8*)(lds + PG8_SA(b, h) + aoff + m * 2048 + k * 1024); } while (0)
#define PG8_LDB(dst, b, h) do { _Pragma("unroll") for (int n = 0; n < 2; ++n) _Pragma("unroll") for (int k = 0; k < 2; ++k) dst[n][k] = *(const PG8_LAS bf16x8*)(lds + PG8_SB(b, h) + boff + n * 2048 + k * 1024); } while (0)
#define PG8_MMA(ai, bj, At, Bt) do { __builtin_amdgcn_s_setprio(1); _Pragma("unroll") for (int m = 0; m < 4; ++m) _Pragma("unroll") for (int n = 0; n < 2; ++n) _Pragma("unroll") for (int k = 0; k < 2; ++k) \
        acc[ai][bj][m][n] = __builtin_amdgcn_mfma_f32_16x16x32_bf16(Bt[n][k], At[m][k], acc[ai][bj][m][n], 0, 0, 0); __builtin_amdgcn_s_setprio(0); } while (0)
#define PG8_WAIT_V(n) asm volatile("s_waitcnt vmcnt(" #n ")" ::: "memory")
#define PG8_WAIT_L(n) asm volatile("s_waitcnt lgkmcnt(" #n ")" ::: "memory")
#define PG8_BAR __builtin_amdgcn_s_barrier()
#define PG8_SCHED __builtin_amdgcn_sched_barrier(0)
    Unit cur, nxt; int ui = 0;
    if (!S.next(0, cur)) return;
    f32x4 acc[2][2][4][2];
#pragma unroll
    for (int a = 0; a < 2; ++a)
#pragma unroll
        for (int b = 0; b < 2; ++b)
#pragma unroll
            for (int m = 0; m < 4; ++m)
#pragma unroll
                for (int n = 0; n < 2; ++n) acc[a][b][m][n] = (f32x4){0.f, 0.f, 0.f, 0.f};
    bf16x8 At[4][2], B0[2][2], B1[2][2];
    const char* cA = (const char*)g.A + (size_t)cur.pm * tstep; const char* cB = (const char*)g.Bt + (size_t)cur.pn * tstep;
    S.a_ready(cur);
    if constexpr (SP2) {
        PG8_STAGE(PG8_SB(0, 0), cB, voffB); PG8_STAGE(PG8_SB(0, 1), cB + hstep, voffB); PG8_STAGE(PG8_SA(0, 0), cA, voffA); PG8_STAGE(PG8_SA(0, 1), cA + hstep, voffA);
        if (wr == 1) PG8_BAR;
        PG8_WAIT_V(2); PG8_BAR;
        PG8_STAGE(PG8_SB(1, 0), cB + kstep, voffB); PG8_STAGE(PG8_SA(1, 0), cA + kstep, voffA); PG8_STAGE(PG8_SB(1, 1), cB + hstep + kstep, voffB);
        PG8_WAIT_V(6); PG8_BAR;
    } else {
        PG8_STAGE(PG8_SB(0, 0), cB, voffB); PG8_STAGE(PG8_SA(0, 0), cA, voffA); PG8_STAGE(PG8_SB(0, 1), cB + hstep, voffB); PG8_STAGE(PG8_SA(0, 1), cA + hstep, voffA);
        if (wr == 1) PG8_BAR;
        PG8_WAIT_V(4); PG8_BAR;
        PG8_STAGE(PG8_SB(1, 0), cB + kstep, voffB); PG8_STAGE(PG8_SA(1, 0), cA + kstep, voffA); PG8_STAGE(PG8_SB(1, 1), cB + hstep + kstep, voffB);
        PG8_WAIT_V(6); PG8_BAR;
    }
    for (;;) {
        const bool has_next = S.next(ui + 1, nxt);
        const char* nA = has_next ? (const char*)g.A + (size_t)nxt.pm * tstep : cA; const char* nB = has_next ? (const char*)g.Bt + (size_t)nxt.pn * tstep : cB;
        for (int t = 0; t < nt; t += 2) {
            const bool last = (t == nt - 2);
            const char* a1 = cA + (size_t)(t + 1) * kstep;
            const char* a2 = last ? nA : cA + (size_t)(t + 2) * kstep; const char* b2 = last ? nB : cB + (size_t)(t + 2) * kstep;
            const char* a3 = a2 + kstep; const char* b3 = b2 + kstep;
            if (last && has_next) S.a_ready(nxt);
            if constexpr (SP2) {
            PG8_LDB(B0, 0, 0); PG8_LDB(B1, 0, 1); PG8_SCHED; PG8_LDA(At, 0, 0); PG8_STAGE(PG8_SA(1, 1), a1 + hstep, voffA);
            PG8_WAIT_V(8); PG8_WAIT_L(0); PG8_BAR; PG8_MMA(0, 0, At, B0); PG8_MMA(0, 1, At, B1); PG8_BAR; PG8_SCHED;
            PG8_LDA(At, 0, 1); PG8_STAGE(PG8_SB(0, 0), b2, voffB); PG8_STAGE(PG8_SB(0, 1), b2 + hstep, voffB); PG8_STAGE(PG8_SA(0, 0), a2, voffA);
            PG8_WAIT_V(8); PG8_WAIT_L(0); PG8_BAR; PG8_MMA(1, 0, At, B0); PG8_MMA(1, 1, At, B1); PG8_BAR; PG8_SCHED;
            PG8_LDB(B0, 1, 0); PG8_LDB(B1, 1, 1); PG8_SCHED; PG8_LDA(At, 1, 0); PG8_STAGE(PG8_SA(0, 1), a2 + hstep, voffA);
            PG8_WAIT_V(8); PG8_WAIT_L(0); PG8_BAR; PG8_MMA(0, 0, At, B0); PG8_MMA(0, 1, At, B1); PG8_BAR; PG8_SCHED;
            PG8_LDA(At, 1, 1); PG8_STAGE(PG8_SB(1, 0), b3, voffB); PG8_STAGE(PG8_SB(1, 1), b3 + hstep, voffB); PG8_STAGE(PG8_SA(1, 0), a3, voffA);
            PG8_WAIT_V(8); PG8_WAIT_L(0); PG8_BAR; PG8_MMA(1, 0, At, B0); PG8_MMA(1, 1, At, B1); PG8_BAR; PG8_SCHED;
            } else {
            PG8_LDB(B0, 0, 0); PG8_SCHED; PG8_LDA(At, 0, 0); PG8_STAGE(PG8_SA(1, 1), a1 + hstep, voffA);
            PG8_WAIT_L(8); PG8_BAR; PG8_WAIT_L(0); PG8_MMA(0, 0, At, B0); PG8_BAR; PG8_SCHED;
            PG8_LDB(B1, 0, 1); PG8_STAGE(PG8_SB(0, 0), b2, voffB);
            PG8_BAR; PG8_WAIT_L(0); PG8_MMA(0, 1, At, B1); PG8_BAR;
            PG8_LDA(At, 0, 1); PG8_STAGE(PG8_SA(0, 0), a2, voffA);
            PG8_BAR; PG8_WAIT_L(0); PG8_MMA(1, 0, At, B0); PG8_BAR; PG8_SCHED;
            PG8_STAGE(PG8_SB(0, 1), b2 + hstep, voffB);
            PG8_WAIT_V(6); PG8_BAR; PG8_MMA(1, 1, At, B1); PG8_BAR;
            PG8_LDB(B0, 1, 0); PG8_SCHED; PG8_LDA(At, 1, 0); PG8_STAGE(PG8_SA(0, 1), a2 + hstep, voffA);
            PG8_WAIT_L(8); PG8_BAR; PG8_WAIT_L(0); PG8_MMA(0, 0, At, B0); PG8_BAR; PG8_SCHED;
            PG8_LDB(B1, 1, 1); PG8_STAGE(PG8_SB(1, 0), b3, voffB);
            PG8_BAR; PG8_WAIT_L(0); PG8_MMA(0, 1, At, B1); PG8_BAR;
            PG8_LDA(At, 1, 1); PG8_STAGE(PG8_SA(1, 0), a3, voffA);
            PG8_BAR; PG8_WAIT_L(0); PG8_MMA(1, 0, At, B0); PG8_BAR; PG8_SCHED;
            PG8_STAGE(PG8_SB(1, 1), b3 + hstep, voffB);
            PG8_WAIT_V(6); PG8_BAR; PG8_MMA(1, 1, At, B1); PG8_BAR;
            }
        }
        if constexpr (ALIGN_EPI) { if (wr == 0) PG8_BAR; }
        if constexpr (!Epi::AFTER_DRAIN) { E(acc, cur, wr, wc, fr, fq); S.done(cur); }
        if (!has_next) break;
#pragma unroll
        for (int a = 0; a < 2; ++a)
#pragma unroll
            for (int b = 0; b < 2; ++b)
#pragma unroll
                for (int m = 0; m < 4; ++m)
#pragma unroll
                    for (int n = 0; n < 2; ++n) acc[a][b][m][n] = (f32x4){0.f, 0.f, 0.f, 0.f};
        cur = nxt; cA = nA; cB = nB; ++ui;
        if constexpr (ALIGN_EPI) { if (wr == 1) PG8_BAR; }
    }
    PG8_WAIT_V(0);
    if constexpr (!ALIGN_EPI) { if (wr == 0) PG8_BAR; }
    PG8_BAR;
    if constexpr (Epi::AFTER_DRAIN) { E.fused(acc, cur, wr, wc, fr, fq, lds, wid, lane); S.done(cur); }
#undef PG8_SA
#undef PG8_SB
#undef PG8_STAGE
#undef PG8_LDA
#undef PG8_LDB
#undef PG8_MMA
#undef PG8_WAIT_V
#undef PG8_WAIT_L
#undef PG8_BAR
#undef PG8_SCHED
}
}

#define LAS __attribute__((address_space(3)))
typedef unsigned short bf16;
typedef float f32x2 __attribute__((ext_vector_type(2)));
typedef float f32x4 __attribute__((ext_vector_type(4)));
typedef unsigned u32x4 __attribute__((ext_vector_type(4)));
typedef unsigned u32x2 __attribute__((ext_vector_type(2)));

constexpr int T = 16384, D = 1024, FF = 2816, DEPTH = 4;
constexpr int DINA = 1792, DINE = 3328, DINO = 1536;
constexpr int NTHREADS = 512, NWAVES = 8;
constexpr int LDS_BYTES = 135168;
constexpr int LCH = 64, NCH = T / LCH;
constexpr int RLCH = 64, RNCH = T / RLCH;

enum { I_X = 0, I_NORMG, I_WG, I_WU, I_WD, I_EWIN, I_EWOUT, I_AMU, I_AW0, I_AWUP, I_AA0, I_AAUP, I_AGUP, I_AKK, I_AKA, I_ARK, I_ALNW, I_ALNB,
       I_AV0, I_AVDN, I_AVUP, I_BCONV, I_OWIN, I_OWOUT, I_CCONVW, I_CCONVB, I_CWA, I_CBA, I_CWX, I_CBX, I_CLAM, I_DW, I_DSCALE, I_FINALG, N_IN };

constexpr size_t OFF_W = 0, SZ_W = 17301504;
constexpr size_t OFF_WB = OFF_W + 11534336;
constexpr size_t OFF_X = OFF_W + SZ_W, SZ_X = (size_t)T * D * 4;
constexpr size_t OFF_VF = OFF_X + SZ_X, SZ_VF = (size_t)T * 512 * 2;
constexpr size_t OFF_H = OFF_VF + SZ_VF, SZ_H = (size_t)T * D * 2;
constexpr size_t OFF_U = OFF_H + SZ_H;
constexpr size_t OFF_ACT = OFF_U;
constexpr size_t OFF_PA = OFF_U;
constexpr size_t OFF_DEC = OFF_PA + (size_t)T * DINA * 2;
constexpr size_t OFF_A16 = OFF_DEC + (size_t)T * 512 * 4;
constexpr size_t OFF_PB = OFF_DEC;
constexpr size_t OFF_V16 = OFF_A16 + (size_t)T * 512 * 2;
constexpr size_t OFF_G16 = OFF_V16 + (size_t)T * 512 * 2;
constexpr size_t OFF_MCM = OFF_G16 + (size_t)T * 512 * 2;
constexpr size_t OFF_MIXE = OFF_MCM;
constexpr size_t OFF_MCC = OFF_MCM + (size_t)NCH * 8 * 4096 * 4;
constexpr size_t SZ_U = (OFF_MCC + (size_t)NCH * 8 * 4096 * 4) - OFF_U;
constexpr size_t OFF_PO = OFF_U;
constexpr size_t OFF_LA = OFF_PO + (size_t)T * DINO * 2;
constexpr size_t OFF_LBX = OFF_LA + (size_t)T * 512 * 4;
constexpr size_t OFF_CHA = OFF_LBX + (size_t)T * 512 * 4;
constexpr size_t OFF_CHB = OFF_CHA + (size_t)NCH * 512 * 4;
constexpr size_t OFF_CAR = OFF_CHB + (size_t)NCH * 512 * 4;
constexpr size_t OFF_MIXO = OFF_CAR + (size_t)NCH * 512 * 4;
constexpr size_t OFF_UC = OFF_MIXO + (size_t)T * D * 2;
constexpr size_t OFF_PD = OFF_UC + (size_t)T * 512 * 2;
constexpr size_t OFF_CTL = OFF_U + SZ_U, SZ_CTL = 16384;
constexpr size_t OFF_MG = OFF_CTL + SZ_CTL, OFF_CG = OFF_MG + 2097152;
constexpr size_t OFF_WCAT = OFF_CG + 2097152;
constexpr size_t OFF_WVDN = OFF_WCAT + (size_t)1536 * 256 * 2;
constexpr size_t OFF_WVUP = OFF_WVDN + (size_t)256 * 512 * 2;
constexpr size_t OFF_LIN = OFF_WVUP + (size_t)512 * 256 * 2;
constexpr size_t OFF_LOW = OFF_LIN + (size_t)T * 256 * 2;
constexpr size_t OFF_WG = OFF_LOW + (size_t)T * 256 * 2;
constexpr size_t OFF_WP = OFF_WG + (size_t)1024 * 512 * 2;
constexpr size_t WS_END = OFF_WP + (size_t)512 * 512 * 2;
static_assert(OFF_PD + (size_t)T * 512 * 2 <= OFF_CTL, "odd map");
static_assert((size_t)T * FF * 2 <= SZ_U, "act map");
static_assert((size_t)T * DINO * 2 == (size_t)T * 512 * 4 + (size_t)T * 512 * 2, "PB overlay");
static_assert((size_t)T * D * 2 <= (size_t)NCH * 8 * 4096 * 4, "MIX overlay");

struct Params { const float* in[N_IN]; float* out; unsigned char* ws; int ph_lo, ph_hi; };

__device__ __forceinline__ float bf2f(bf16 b) { return __uint_as_float(((unsigned)b) << 16); }
__device__ __forceinline__ unsigned f2bf(float f) { unsigned u = __float_as_uint(f); return (u + 0x7fffu + ((u >> 16) & 1u)) >> 16; }
__device__ __forceinline__ unsigned pk2(float lo, float hi) { return f2bf(lo) | (f2bf(hi) << 16); }
template <int CTRL> __device__ __forceinline__ float dpp_mov(float v) { return __int_as_float(__builtin_amdgcn_update_dpp(0, __float_as_int(v), CTRL, 0xF, 0xF, true)); }
__device__ __forceinline__ float wave_sum(float v) {
    v += dpp_mov<0xB1>(v); v += dpp_mov<0x4E>(v); v += dpp_mov<0x141>(v); v += dpp_mov<0x140>(v);
    const float s0 = __int_as_float(__builtin_amdgcn_readlane(__float_as_int(v), 0)), s1 = __int_as_float(__builtin_amdgcn_readlane(__float_as_int(v), 16));
    const float s2 = __int_as_float(__builtin_amdgcn_readlane(__float_as_int(v), 32)), s3 = __int_as_float(__builtin_amdgcn_readlane(__float_as_int(v), 48));
    return (s0 + s1) + (s2 + s3);
}
__device__ __forceinline__ float frcp(float x) { return __builtin_amdgcn_rcpf(x); }
__device__ __forceinline__ float frsq(float x) { return __builtin_amdgcn_rsqf(x); }
__device__ __forceinline__ float sigm(float x) { return frcp(1.f + __expf(-x)); }
__device__ __forceinline__ float tanh_fast(float x) { return 1.f - 2.f * frcp(1.f + __expf(2.f * x)); }
#define LDS_WAIT() asm volatile("s_waitcnt lgkmcnt(0)" ::: "memory")
template <class Tp> __device__ __forceinline__ const Tp* opaque(const Tp* p) { asm volatile("" : "+v"(p)); return p; }

template <int K> __device__ __forceinline__ float dot_bcast(const LAS float* x, const f32x2 (&w2)[K / 2]) {
    f32x2 a0 = {0.f, 0.f}, a1 = {0.f, 0.f};
#pragma unroll
    for (int q = 0; q < K / 4; ++q) {
        const f32x4 v = *(const LAS f32x4*)(x + 4 * q);
        a0 += (f32x2){v.x, v.y} * w2[2 * q];
        a1 += (f32x2){v.z, v.w} * w2[2 * q + 1];
    }
    return (a0.x + a0.y) + (a1.x + a1.y);
}

struct EpiSwiglu {
    static constexpr bool PERM = true, AFTER_DRAIN = false;
    bf16* O;
    __device__ __forceinline__ void operator()(const f32x4 (&acc)[2][2][4][2], const pg8::Unit& u, int wr, int wc, int fr, int fq) const {
        const int row0 = u.pm * 256 + wr * 64 + fr, col0 = u.pn * 128 + wc * 32 + 8 * fq;
#pragma unroll
        for (int ai = 0; ai < 2; ++ai)
#pragma unroll
            for (int m = 0; m < 4; ++m) {
                bf16* rowp = O + (size_t)(row0 + ai * 128 + m * 16) * FF + col0;
                float r[8];
#pragma unroll
                for (int n = 0; n < 2; ++n)
#pragma unroll
                    for (int i = 0; i < 4; ++i) { const float g = acc[ai][0][m][n][i], up = acc[ai][1][m][n][i]; r[n * 4 + i] = g * up * frcp(1.f + __expf(-g)); }
                u32x4 w; w.x = pg8::cvt_pk_bf16(r[0], r[1]); w.y = pg8::cvt_pk_bf16(r[2], r[3]); w.z = pg8::cvt_pk_bf16(r[4], r[5]); w.w = pg8::cvt_pk_bf16(r[6], r[7]);
                *(u32x4*)rowp = w;
            }
    }
};
struct EpiResid {
    static constexpr bool PERM = false, AFTER_DRAIN = false;
    const float* Xin; float* Xout; float scale;
    __device__ __forceinline__ void operator()(const f32x4 (&acc)[2][2][4][2], const pg8::Unit& u, int wr, int wc, int fr, int fq) const {
        const int row0 = u.pm * 256 + wr * 64 + fr, col0 = u.pn * 256 + wc * 32 + 4 * fq;
#pragma unroll
        for (int ai = 0; ai < 2; ++ai)
#pragma unroll
            for (int mh = 0; mh < 2; ++mh) {
                f32x4 xi[2][2][2];
#pragma unroll
                for (int m = 0; m < 2; ++m)
#pragma unroll
                    for (int bj = 0; bj < 2; ++bj)
#pragma unroll
                        for (int n = 0; n < 2; ++n) xi[m][bj][n] = *(const f32x4*)(Xin + (size_t)(row0 + ai * 128 + (2 * mh + m) * 16) * D + col0 + bj * 128 + n * 16);
                __builtin_amdgcn_sched_barrier(0);
#pragma unroll
                for (int m = 0; m < 2; ++m)
#pragma unroll
                    for (int bj = 0; bj < 2; ++bj)
#pragma unroll
                        for (int n = 0; n < 2; ++n) *(f32x4*)(Xout + (size_t)(row0 + ai * 128 + (2 * mh + m) * 16) * D + col0 + bj * 128 + n * 16) = xi[m][bj][n] + acc[ai][bj][2 * mh + m][n] * scale;
                __builtin_amdgcn_sched_barrier(0);
            }
    }
};
struct EpiStoreBf16 {
    static constexpr bool PERM = true, AFTER_DRAIN = false;
    bf16* O; int ldc;
    __device__ __forceinline__ void operator()(const f32x4 (&acc)[2][2][4][2], const pg8::Unit& u, int wr, int wc, int fr, int fq) const {
        const int row0 = u.pm * 256 + wr * 64 + fr, col0 = u.pn * 256 + wc * 32 + 8 * fq;
#pragma unroll
        for (int ai = 0; ai < 2; ++ai)
#pragma unroll
            for (int m = 0; m < 4; ++m) {
                bf16* rowp = O + (size_t)(row0 + ai * 128 + m * 16) * ldc + col0;
#pragma unroll
                for (int bj = 0; bj < 2; ++bj) { const f32x4 v0 = acc[ai][bj][m][0], v1 = acc[ai][bj][m][1];
                    u32x4 w; w.x = pg8::cvt_pk_bf16(v0[0], v0[1]); w.y = pg8::cvt_pk_bf16(v0[2], v0[3]); w.z = pg8::cvt_pk_bf16(v1[0], v1[1]); w.w = pg8::cvt_pk_bf16(v1[2], v1[3]);
                    *(u32x4*)(rowp + bj * 128) = w; }
            }
    }
};
template <class Epi> __device__ __forceinline__ void run_gemm(LAS unsigned char* lds, const bf16* A, const bf16* Bt, int M, int N, int K, const Epi& E) {
    asm volatile("" : "+s"(K));
    pg8::Gemm g{A, Bt, M, N, K}; pg8::StaticOrder S; S.init(M, N, (int)gridDim.x, (int)blockIdx.x);
    pg8::gemm_phase<Epi, pg8::StaticOrder, true, true>(lds, g, S, E);
}

__device__ __forceinline__ void transpose_item(const float* __restrict__ W, int K, int N, bf16* WT, int mode, LAS float* scr, int item, int lane) {
    const int nblk = N / 32, kb = item / nblk, nb = item % nblk, k0 = 64 * kb, n0 = 32 * nb;
    float tv[32];
#pragma unroll
    for (int i = 0; i < 32; ++i) { const int kk = 2 * i + (lane >> 5); tv[i] = W[(size_t)(k0 + kk) * N + n0 + (lane & 31)]; }
    __builtin_amdgcn_sched_barrier(0);
#pragma unroll
    for (int i = 0; i < 32; ++i) { const int kk = 2 * i + (lane >> 5); scr[kk * 33 + (lane & 31)] = tv[i]; }
    LDS_WAIT();
    const int c = lane & 7;
    const int drow0 = mode == 0 ? n0 : (256 * (n0 >> 7) + (n0 & 127) + (mode == 2 ? 128 : 0));
#pragma unroll
    for (int j = 0; j < 4; ++j) { const int n = (lane >> 3) + 8 * j; const LAS float* s = scr + (8 * c) * 33 + n;
        u32x4 o; o.x = pk2(s[0 * 33], s[1 * 33]); o.y = pk2(s[2 * 33], s[3 * 33]); o.z = pk2(s[4 * 33], s[5 * 33]); o.w = pk2(s[6 * 33], s[7 * 33]);
        *(u32x4*)(WT + (size_t)(drow0 + n) * K + k0 + 8 * c) = o; }
    LDS_WAIT();
}
__device__ __forceinline__ void conv_matrix(const float* W, int K, int N, bf16* WT, int mode, LAS float* scr, int gw, int ngw, int lane) {
    const int items = (K / 64) * (N / 32);
    for (int it = gw; it < items; it += ngw) transpose_item(W, K, N, WT, mode, scr, it, lane);
}
__device__ __forceinline__ void rmsnorm_rows(const float* X, const float* g, bf16* H, float* Of, int gw, int ngw, int lane) {
    f32x4 gv[4];
#pragma unroll
    for (int j = 0; j < 4; ++j) gv[j] = *(const f32x4*)(g + 4 * lane + 256 * j);
    for (int row0 = 4 * gw; row0 < T; row0 += 4 * ngw) {
        f32x4 v[4][4]; float s[4] = {0.f, 0.f, 0.f, 0.f};
#pragma unroll
        for (int r = 0; r < 4; ++r)
#pragma unroll
            for (int j = 0; j < 4; ++j) v[r][j] = *(const f32x4*)(X + (size_t)(row0 + r) * D + 4 * lane + 256 * j);
        __builtin_amdgcn_sched_barrier(0);
#pragma unroll
        for (int r = 0; r < 4; ++r)
#pragma unroll
            for (int j = 0; j < 4; ++j) s[r] += (v[r][j].x * v[r][j].x + v[r][j].y * v[r][j].y) + (v[r][j].z * v[r][j].z + v[r][j].w * v[r][j].w);
#pragma unroll
        for (int r = 0; r < 4; ++r) {
            const float rstd = frsq(wave_sum(s[r]) * (1.f / D) + 1e-6f);
#pragma unroll
            for (int j = 0; j < 4; ++j) {
                const f32x4 o = v[r][j] * rstd * gv[j];
                if (Of) *(f32x4*)(Of + (size_t)(row0 + r) * D + 4 * lane + 256 * j) = o;
                else { u32x2 w; w.x = pk2(o.x, o.y); w.y = pk2(o.z, o.w); *(u32x2*)(H + (size_t)(row0 + r) * D + 4 * lane + 256 * j) = w; }
            }
        }
    }
}

__device__ __forceinline__ void stage_images(const Params& P, int odd, int idx) {
    unsigned char* ws = P.ws;
    int tid = threadIdx.x; asm volatile("" : "+v"(tid));
    const size_t gt = (size_t)blockIdx.x * NTHREADS + tid, ngt = (size_t)gridDim.x * NTHREADS;
    if (!odd) {
        const int e = idx;
    {
        bf16* WC = (bf16*)(ws + OFF_WCAT); bf16* WDN = (bf16*)(ws + OFF_WVDN); bf16* WUP = (bf16*)(ws + OFF_WVUP);
        const float* w_up = P.in[I_AWUP] + (size_t)e * 64 * 512; const float* a_up = P.in[I_AAUP] + (size_t)e * 64 * 512; const float* g_up = P.in[I_AGUP] + (size_t)e * 128 * 512;
        for (size_t i = gt; i < (size_t)1536 * 256; i += ngt) {
            const int n = (int)(i >> 8), k = (int)(i & 255); float v = 0.f;
            if (n < 512) { if (k < 64) v = w_up[(size_t)k * 512 + n]; }
            else if (n < 1024) { if (k >= 64 && k < 128) v = a_up[(size_t)(k - 64) * 512 + (n - 512)]; }
            else { if (k >= 128) v = g_up[(size_t)(k - 128) * 512 + (n - 1024)]; }
            WC[i] = (bf16)f2bf(v);
        }
        if (e > 0) {
            const float* v_dn = P.in[I_AVDN] + (size_t)(e - 1) * 512 * 32; const float* v_up = P.in[I_AVUP] + (size_t)(e - 1) * 32 * 512;
            for (size_t i = gt; i < (size_t)256 * 512; i += ngt) { const int n = (int)(i >> 9), k = (int)(i & 511); WDN[i] = (bf16)f2bf(n < 32 ? v_dn[(size_t)k * 32 + n] : 0.f); }
            for (size_t i = gt; i < (size_t)512 * 256; i += ngt) { const int n = (int)(i >> 8), k = (int)(i & 255); WUP[i] = (bf16)f2bf(k < 32 ? v_up[(size_t)k * 512 + n] : 0.f); }
        }
    }
    } else {
        const int o = idx;
    {
        bf16* WG = (bf16*)(ws + OFF_WG); bf16* WP = (bf16*)(ws + OFF_WP);
        const float* wa = P.in[I_CWA] + (size_t)o * 8 * 4096; const float* wx = P.in[I_CWX] + (size_t)o * 8 * 4096; const float* dw = P.in[I_DW] + (size_t)o * 4 * 16384;
        for (size_t i = gt; i < (size_t)1024 * 512; i += ngt) {
            const int n = (int)(i >> 9), k = (int)(i & 511), nn = n & 511, h = nn >> 6;
            float v = 0.f;
            if ((k >> 6) == h) v = (n < 512 ? wa : wx)[(size_t)h * 4096 + (size_t)(k & 63) * 64 + (nn & 63)];
            WG[i] = (bf16)f2bf(v);
        }
        for (size_t i = gt; i < (size_t)512 * 512; i += ngt) {
            const int n = (int)(i >> 9), k = (int)(i & 511), g = n >> 7;
            WP[i] = (bf16)f2bf((k >> 7) == g ? dw[(size_t)g * 16384 + (size_t)(k & 127) * 128 + (n & 127)] : 0.f);
        }
    }
    }
}
__device__ __forceinline__ void stage_prepE(const Params& P, int e) {
    unsigned char* ws = P.ws;
    const bf16* PA = (const bf16*)(ws + OFF_PA);
    bf16* LIN = (bf16*)(ws + OFF_LIN); bf16* VDST = (bf16*)(ws + (e == 0 ? OFF_VF : OFF_V16));
    const float* mu = P.in[I_AMU] + (size_t)e * DINA;
    int tid = threadIdx.x; asm volatile("" : "+v"(tid));
    const size_t gt = (size_t)blockIdx.x * NTHREADS + tid, ngt = (size_t)gridDim.x * NTHREADS;
    stage_images(P, 0, e);
    for (size_t it = gt; it < (size_t)(T / 16) * 768; it += ngt) {
        const int tile = (int)(it / 768), c = (int)(it % 768), t0 = tile * 16;
        const int col = c < 256 ? 1536 + c : 1024 + (c - 256);
        const float m = mu[col];
        float pv[17]; bf16 raw[17];
#pragma unroll
        for (int i = 0; i < 17; ++i) { const int tg = t0 - 1 + i; raw[i] = PA[(size_t)(tg > 0 ? tg : 0) * DINA + col]; }
        __builtin_amdgcn_sched_barrier(0);
#pragma unroll
        for (int i = 0; i < 17; ++i) { const int tg = t0 - 1 + i; pv[i] = tg >= 0 ? bf2f(raw[i]) : 0.f; }
#pragma unroll
        for (int i = 0; i < 16; ++i) {
            float x = pv[i + 1] + (pv[i] - pv[i + 1]) * m;
            if (c < 256) { if (c < 64) x = tanh_fast(x); else if (c >= 128) x = sigm(x); LIN[(size_t)(t0 + i) * 256 + c] = (bf16)f2bf(x); }
            else VDST[(size_t)(t0 + i) * 512 + (c - 256)] = (bf16)f2bf(x);
        }
    }
}
struct EpiLora {
    static constexpr bool PERM = true, AFTER_DRAIN = false;
    unsigned char* wsb; const float* w0; const float* a0;
    __device__ __forceinline__ void operator()(const f32x4 (&acc)[2][2][4][2], const pg8::Unit& u, int wr, int wc, int fr, int fq) const {
        const int row0 = u.pm * 256 + wr * 64 + fr, kind = u.pn >> 1, colb = (u.pn & 1) * 256 + wc * 32 + 8 * fq;
        float* DEC = (float*)(wsb + OFF_DEC); bf16* O16 = (bf16*)(wsb + (kind == 1 ? OFF_A16 : OFF_G16));
#pragma unroll
        for (int bj = 0; bj < 2; ++bj) {
            const int col = colb + bj * 128;
            f32x4 b0 = {0.f, 0.f, 0.f, 0.f}, b1 = {0.f, 0.f, 0.f, 0.f};
            if (kind == 0) { b0 = *(const f32x4*)(w0 + col); b1 = *(const f32x4*)(w0 + col + 4); }
            else if (kind == 1) { b0 = *(const f32x4*)(a0 + col); b1 = *(const f32x4*)(a0 + col + 4); }
#pragma unroll
            for (int ai = 0; ai < 2; ++ai)
#pragma unroll
                for (int m = 0; m < 4; ++m) {
                    const size_t off = (size_t)(row0 + ai * 128 + m * 16) * 512 + col;
                    f32x4 v0 = acc[ai][bj][m][0] + b0, v1 = acc[ai][bj][m][1] + b1;
                    if (kind == 0) {
#pragma unroll
                        for (int i = 0; i < 4; ++i) {
                            { const float z = -v0[i]; const float sp_ = fmaxf(z, 0.f) + __logf(1.f + __expf(-fabsf(z))); v0[i] = __expf(-__expf(-sp_ - 0.5f)); }
                            { const float z = -v1[i]; const float sp_ = fmaxf(z, 0.f) + __logf(1.f + __expf(-fabsf(z))); v1[i] = __expf(-__expf(-sp_ - 0.5f)); }
                        }
                        *(f32x4*)(DEC + off) = v0; *(f32x4*)(DEC + off + 4) = v1;
                    } else {
                        if (kind == 1) {
#pragma unroll
                            for (int i = 0; i < 4; ++i) { v0[i] = sigm(v0[i]); v1[i] = sigm(v1[i]); }
                        }
                        u32x4 w; w.x = pg8::cvt_pk_bf16(v0[0], v0[1]); w.y = pg8::cvt_pk_bf16(v0[2], v0[3]); w.z = pg8::cvt_pk_bf16(v1[0], v1[1]); w.w = pg8::cvt_pk_bf16(v1[2], v1[3]);
                        *(u32x4*)(O16 + off) = w;
                    }
                }
        }
    }
};
struct EpiVres {
    static constexpr bool PERM = true, AFTER_DRAIN = false;
    bf16* V; const bf16* VF; const float* v0;
    __device__ __forceinline__ void operator()(const f32x4 (&acc)[2][2][4][2], const pg8::Unit& u, int wr, int wc, int fr, int fq) const {
        const int row0 = u.pm * 256 + wr * 64 + fr, colb = u.pn * 256 + wc * 32 + 8 * fq;
#pragma unroll
        for (int bj = 0; bj < 2; ++bj) {
            const int col = colb + bj * 128;
            const f32x4 b0 = *(const f32x4*)(v0 + col), b1 = *(const f32x4*)(v0 + col + 4);
#pragma unroll
            for (int ai = 0; ai < 2; ++ai) {
                u32x4 vr[4], fr_[4];
#pragma unroll
                for (int m = 0; m < 4; ++m) { const size_t off = (size_t)(row0 + ai * 128 + m * 16) * 512 + col; vr[m] = *(const u32x4*)(V + off); fr_[m] = *(const u32x4*)(VF + off); }
                __builtin_amdgcn_sched_barrier(0);
#pragma unroll
                for (int m = 0; m < 4; ++m) {
                    const size_t off = (size_t)(row0 + ai * 128 + m * 16) * 512 + col;
                    const f32x4 g0 = acc[ai][bj][m][0] + b0, g1 = acc[ai][bj][m][1] + b1;
                    float o[8];
#pragma unroll
                    for (int i = 0; i < 8; ++i) {
                        const unsigned vw = vr[m][i >> 1], fw = fr_[m][i >> 1];
                        const float v = __uint_as_float((i & 1) ? (vw & 0xffff0000u) : (vw << 16)), vf = __uint_as_float((i & 1) ? (fw & 0xffff0000u) : (fw << 16));
                        const float gate = sigm(i < 4 ? g0[i] : g1[i - 4]);
                        o[i] = v + (vf - v) * gate;
                    }
                    u32x4 w; w.x = pg8::cvt_pk_bf16(o[0], o[1]); w.y = pg8::cvt_pk_bf16(o[2], o[3]); w.z = pg8::cvt_pk_bf16(o[4], o[5]); w.w = pg8::cvt_pk_bf16(o[6], o[7]);
                    *(u32x4*)(V + off) = w;
                }
                __builtin_amdgcn_sched_barrier(0);
            }
        }
    }
};

template <int MODE> __device__ __forceinline__ void rwkv_item(const Params& P, int e, int c, int h, LAS float* slab, int lane) {
    unsigned char* ws = P.ws;
    const bf16* PA = (const bf16*)(ws + OFF_PA);
    const float* DEC = (const float*)(ws + OFF_DEC); const bf16* A16 = (const bf16*)(ws + OFF_A16); const bf16* G16 = (const bf16*)(ws + OFF_G16);
    const bf16* V16 = (const bf16*)(ws + (e == 0 ? OFF_VF : OFF_V16));
    float* MCM = (float*)(ws + OFF_MCM); float* MCC = (float*)(ws + OFF_MCC); bf16* MIX = (bf16*)(ws + OFF_MIXE);
    const int ch = h * 64 + lane;
    const float mu_r = P.in[I_AMU][(size_t)e * DINA + ch], mu_k = P.in[I_AMU][(size_t)e * DINA + 512 + ch];
    const float kkw = P.in[I_AKK][e * 512 + ch], ka = P.in[I_AKA][e * 512 + ch], rk = P.in[I_ARK][e * 512 + ch];
    const float lnw = P.in[I_ALNW][e * 512 + ch], lnb = P.in[I_ALNB][e * 512 + ch];
    constexpr int SB = MODE == 0 ? 4 : 8;
    f32x2 S2[32], C2[MODE == 0 ? 32 : 1];
    const size_t rowoff = (((size_t)c * 8 + h) * 64 + lane) * 64;
    if (MODE == 0) {
#pragma unroll
        for (int i = 0; i < 32; ++i) { S2[i] = (f32x2){(2 * i) == lane ? 1.f : 0.f, (2 * i + 1) == lane ? 1.f : 0.f}; C2[i] = (f32x2){0.f, 0.f}; }
    } else {
#pragma unroll
        for (int q = 0; q < 16; ++q) { const f32x4 v = *(const f32x4*)(MCC + rowoff + 4 * q); S2[2 * q] = (f32x2){v.x, v.y}; S2[2 * q + 1] = (f32x2){v.z, v.w}; }
    }
    float r1[SB + 1], k1[SB + 1], vv[SB], dd[SB], aa[SB], gg[MODE == 1 ? SB : 1];
#define RW_LOAD(tb_) do { { const int tp_ = (tb_) - 1; const size_t pq_ = (size_t)(tp_ > 0 ? tp_ : 0) * DINA + ch; const float ra_ = bf2f(PA[pq_]), ka_ = bf2f(PA[pq_ + 512]); r1[0] = tp_ >= 0 ? ra_ : 0.f; k1[0] = tp_ >= 0 ? ka_ : 0.f; } \
        _Pragma("unroll") for (int s_ = 0; s_ < SB; ++s_) { const int t_ = (tb_) + s_; const size_t pr_ = (size_t)t_ * DINA + ch; \
        r1[s_ + 1] = bf2f(PA[pr_]); k1[s_ + 1] = bf2f(PA[pr_ + 512]); \
        vv[s_] = bf2f(V16[(size_t)t_ * 512 + ch]); dd[s_] = DEC[(size_t)t_ * 512 + ch]; aa[s_] = bf2f(A16[(size_t)t_ * 512 + ch]); \
        if (MODE == 1) gg[s_] = bf2f(G16[(size_t)t_ * 512 + ch]); } } while (0)
    if (MODE == 1) RW_LOAD(c * RLCH);
    for (int sb = 0; sb < RLCH / SB; ++sb) {
        const int tb = c * RLCH + sb * SB;
        if (MODE == 0) RW_LOAD(tb);
#pragma unroll
        for (int s = 0; s < SB; ++s) {
            const float r = r1[s + 1] + (r1[s] - r1[s + 1]) * mu_r, k = k1[s + 1] + (k1[s] - k1[s + 1]) * mu_k, a = aa[s];
            float kk = k * kkw;
            const float ss = wave_sum(kk * kk);
            kk *= frsq(fmaxf(ss, 1e-24f));
            const float b = kk * a, kp = k * (1.f + (a - 1.f) * ka);
            LAS float* st = slab + s * 512;
            st[lane] = dd[s]; st[64 + lane] = kk; st[128 + lane] = b; st[192 + lane] = kp; st[256 + lane] = r; st[320 + lane] = vv[s];
            if (MODE == 1) { st[384 + lane] = wave_sum(r * kp * rk); st[448 + lane] = gg[s]; }
        }
        LDS_WAIT();
        if (MODE == 1 && sb + 1 < RLCH / SB) RW_LOAD(tb + SB);
#pragma unroll 1
        for (int s = 0; s < SB; ++s) {
            const LAS float* st = slab + s * 512;
            f32x2 aS0 = {0.f, 0.f}, aS1 = {0.f, 0.f}, aC0 = {0.f, 0.f}, aC1 = {0.f, 0.f};
            constexpr int DB = 4, UB = 2;
            constexpr int NDB = 16 / DB, NUB = 16 / UB;
            constexpr int NB = MODE == 1 ? 2 : 1;
            f32x4 kd[NB][DB];
            f32x4 wq[NB][UB], bq[NB][UB], kq[NB][UB], rq[NB][MODE == 1 ? UB : 1];
#define RW_LD_DOT(buf, hb) do { _Pragma("unroll") for (int q_ = 0; q_ < DB; ++q_) kd[buf][q_] = *(const LAS f32x4*)(st + 64 + 4 * (DB * (hb) + q_)); } while (0)
#define RW_LD_UPD(buf, qb) do { _Pragma("unroll") for (int q_ = 0; q_ < UB; ++q_) { const int qq_ = UB * (qb) + q_; \
                wq[buf][q_] = *(const LAS f32x4*)(st + 4 * qq_); bq[buf][q_] = *(const LAS f32x4*)(st + 128 + 4 * qq_); kq[buf][q_] = *(const LAS f32x4*)(st + 192 + 4 * qq_); \
                if (MODE == 1) rq[buf][q_] = *(const LAS f32x4*)(st + 256 + 4 * qq_); } } while (0)
            if (NB == 2) RW_LD_DOT(0, 0);
            const float v = st[320 + lane];
#pragma unroll
            for (int hb = 0; hb < NDB; ++hb) {
                if (NB == 2) { if (hb + 1 < NDB) RW_LD_DOT((hb + 1) & 1, hb + 1); else RW_LD_UPD(0, 0); } else RW_LD_DOT(0, hb);
                __builtin_amdgcn_sched_barrier(0);
#pragma unroll
                for (int q = 0; q < DB; ++q) {
                    const int qq = DB * hb + q; const f32x4 k4 = kd[hb & (NB - 1)][q];
                    aS0 += S2[2 * qq] * (f32x2){k4.x, k4.y}; aS1 += S2[2 * qq + 1] * (f32x2){k4.z, k4.w};
                    if (MODE == 0) { aC0 += C2[2 * qq] * (f32x2){k4.x, k4.y}; aC1 += C2[2 * qq + 1] * (f32x2){k4.z, k4.w}; }
                }
                __builtin_amdgcn_sched_barrier(0);
            }
            const float nsk = -((aS0.x + aS0.y) + (aS1.x + aS1.y));
            const float nskC = -((aC0.x + aC0.y) + (aC1.x + aC1.y));
            f32x2 y0 = {0.f, 0.f}, y1 = {0.f, 0.f};
#pragma unroll
            for (int qb = 0; qb < NUB; ++qb) {
                if (NB == 2) { if (qb + 1 < NUB) RW_LD_UPD((qb + 1) & 1, qb + 1); } else RW_LD_UPD(0, qb);
                __builtin_amdgcn_sched_barrier(0);
#pragma unroll
                for (int q = 0; q < UB; ++q) {
                    const int qq = UB * qb + q;
                    const f32x4 w4 = wq[qb & (NB - 1)][q], b4 = bq[qb & (NB - 1)][q], k4 = kq[qb & (NB - 1)][q];
                    if (MODE == 0) {
                        S2[2 * qq] = S2[2 * qq] * (f32x2){w4.x, w4.y} + (f32x2){b4.x, b4.y} * nsk;
                        S2[2 * qq + 1] = S2[2 * qq + 1] * (f32x2){w4.z, w4.w} + (f32x2){b4.z, b4.w} * nsk;
                        C2[2 * qq] = C2[2 * qq] * (f32x2){w4.x, w4.y} + (f32x2){b4.x, b4.y} * nskC + (f32x2){k4.x, k4.y} * v;
                        C2[2 * qq + 1] = C2[2 * qq + 1] * (f32x2){w4.z, w4.w} + (f32x2){b4.z, b4.w} * nskC + (f32x2){k4.z, k4.w} * v;
                    } else {
                        S2[2 * qq] = S2[2 * qq] * (f32x2){w4.x, w4.y} + (f32x2){b4.x, b4.y} * nsk + (f32x2){k4.x, k4.y} * v;
                        S2[2 * qq + 1] = S2[2 * qq + 1] * (f32x2){w4.z, w4.w} + (f32x2){b4.z, b4.w} * nsk + (f32x2){k4.z, k4.w} * v;
                        const f32x4 r4 = rq[qb & (NB - 1)][q]; y0 += S2[2 * qq] * (f32x2){r4.x, r4.y}; y1 += S2[2 * qq + 1] * (f32x2){r4.z, r4.w};
                    }
                }
                __builtin_amdgcn_sched_barrier(0);
            }
#undef RW_LD_DOT
#undef RW_LD_UPD
            if (MODE == 1) ((LAS float*)st)[lane] = (y0.x + y0.y) + (y1.x + y1.y);
        }
        if (MODE == 1) {
            LDS_WAIT();
#pragma unroll
            for (int s = 0; s < SB; ++s) {
                const LAS float* st = slab + s * 512;
                const float y = st[lane], v = st[320 + lane];
                const float mean = wave_sum(y) * (1.f / 64.f), d = y - mean;
                const float var = wave_sum(d * d) * (1.f / 64.f);
                const float yn = d * frsq(var + 64e-5f) * lnw + lnb;
                MIX[(size_t)(tb + s) * D + ch] = (bf16)f2bf((yn + st[384 + lane] * v) * st[448 + lane]);
            }
        }
        LDS_WAIT();
    }
#undef RW_LOAD
    if (MODE == 0) {
#pragma unroll
        for (int q = 0; q < 16; ++q) {
            *(f32x4*)(MCM + rowoff + 4 * q) = (f32x4){S2[2 * q].x, S2[2 * q].y, S2[2 * q + 1].x, S2[2 * q + 1].y};
            *(f32x4*)(MCC + rowoff + 4 * q) = (f32x4){C2[2 * q].x, C2[2 * q].y, C2[2 * q + 1].x, C2[2 * q + 1].y};
        }
    }
}
template <int MODE> __device__ __forceinline__ void stage_rwkv_scan(const Params& P, int e, LAS unsigned char* lds) {
    int tid = threadIdx.x; asm volatile("" : "+v"(tid)); const int lane = tid & 63, wave = __builtin_amdgcn_readfirstlane(tid >> 6);
    LAS float* slab = (LAS float*)(lds + wave * 16384);
    const int gw = blockIdx.x * NWAVES + wave, ngw = gridDim.x * NWAVES;
    for (int it = gw; it < RNCH * 8; it += ngw) rwkv_item<MODE>(P, e, it >> 3, it & 7, slab, lane);
}

constexpr int P2_GS = 16, P2_NG = RNCH / P2_GS;
template <bool HAS_C, bool STORE_STEPS>
__device__ __forceinline__ void chain16(f32x4 (&acc)[4], const float* Mb, size_t mstride, float* Cb, size_t cstride, int nsteps) {
    f32x4 mc[16];
#pragma unroll
    for (int i = 0; i < 16; ++i) mc[i] = *(const f32x4*)(Mb + (size_t)i * 64);
    f32x4 qn[4];
    if (HAS_C) {
#pragma unroll
        for (int j = 0; j < 4; ++j) qn[j] = *(const f32x4*)(Cb + 4 * j);
    }
    for (int c = 0; c < nsteps; ++c) {
        float* cp = Cb + (size_t)c * cstride;
        f32x4 q[4];
        if (HAS_C) {
#pragma unroll
            for (int j = 0; j < 4; ++j) q[j] = qn[j];
            const float* cn = Cb + (size_t)(c + 1 < nsteps ? c + 1 : c) * cstride;
#pragma unroll
            for (int j = 0; j < 4; ++j) qn[j] = *(const f32x4*)(cn + 4 * j);
        }
        f32x4 mn[16];
        const float* Mn = Mb + (size_t)(c + 1 < nsteps ? c + 1 : c) * mstride;
#pragma unroll
        for (int i = 0; i < 16; ++i) mn[i] = *(const f32x4*)(Mn + (size_t)i * 64);
        if (STORE_STEPS) {
#pragma unroll
            for (int j = 0; j < 4; ++j) *(f32x4*)(cp + 4 * j) = (f32x4){acc[0][j], acc[1][j], acc[2][j], acc[3][j]};
        }
        f32x4 na[4];
#pragma unroll
        for (int n = 0; n < 4; ++n) na[n] = HAS_C ? (f32x4){q[0][n], q[1][n], q[2][n], q[3][n]} : (f32x4){0.f, 0.f, 0.f, 0.f};
#pragma unroll
        for (int n = 0; n < 4; ++n)
#pragma unroll
            for (int j = 0; j < 4; ++j) {
                const f32x4 a4 = mc[4 * j + n];
#pragma unroll
                for (int np = 0; np < 4; ++np) na[np] = __builtin_amdgcn_mfma_f32_16x16x4f32(a4[np], acc[n][j], na[np], 0, 0, 0);
            }
#pragma unroll
        for (int n = 0; n < 4; ++n) acc[n] = na[n];
#pragma unroll
        for (int i = 0; i < 16; ++i) mc[i] = mn[i];
    }
}
__device__ __forceinline__ void store_strip(const f32x4 (&acc)[4], float* dst) {
#pragma unroll
    for (int j = 0; j < 4; ++j) *(f32x4*)(dst + 4 * j) = (f32x4){acc[0][j], acc[1][j], acc[2][j], acc[3][j]};
}
__device__ __forceinline__ void stage_rwkv_pass2(const Params& P, int level) {
    int tid = threadIdx.x; asm volatile("" : "+v"(tid)); const int lane = tid & 63, wave = __builtin_amdgcn_readfirstlane(tid >> 6);
    unsigned char* ws = P.ws;
    const float* MCM = (const float*)(ws + OFF_MCM); float* MCC = (float*)(ws + OFF_MCC);
    float* MG = (float*)(ws + OFF_MG); float* CG = (float*)(ws + OFF_CG);
    const int rho = lane & 15, g4 = lane >> 4;
    const int gw = blockIdx.x * NWAVES + wave, ngw = gridDim.x * NWAVES;
    f32x4 acc[4];
    if (level == 0) {
        const bool spread = (gridDim.x == 256);
        for (int it0 = spread ? (wave < 4 ? (int)blockIdx.x : P2_NG * 64) : gw; it0 < P2_NG * 8 * 8; it0 += spread ? P2_NG * 64 : ngw) {
            int it = it0;
            if (spread) { const int x = blockIdx.x & 7, j = blockIdx.x >> 3, idx = wave * 32 + j; it = ((idx >> 3) * 8 + x) * 8 + (idx & 7); }
            const int g = it >> 6, h = (it >> 3) & 7, part = (it >> 2) & 1, s = it & 3, v = 16 * s + rho;
            const float* Mb = MCM + ((size_t)(g * P2_GS) * 8 + h) * 4096 + (size_t)(16 * g4) * 64 + 4 * rho;
            float* Cb = MCC + ((size_t)(g * P2_GS) * 8 + h) * 4096 + (size_t)v * 64 + 16 * g4;
            if (part == 0) {
#pragma unroll
                for (int n = 0; n < 4; ++n)
#pragma unroll
                    for (int j = 0; j < 4; ++j) acc[n][j] = (v == 16 * g4 + 4 * j + n) ? 1.f : 0.f;
                chain16<false, false>(acc, Mb, 32768, Cb, 32768, P2_GS);
                store_strip(acc, MG + ((size_t)g * 8 + h) * 4096 + (size_t)v * 64 + 16 * g4);
            } else {
#pragma unroll
                for (int n = 0; n < 4; ++n) acc[n] = (f32x4){0.f, 0.f, 0.f, 0.f};
                chain16<true, false>(acc, Mb, 32768, Cb, 32768, P2_GS);
                store_strip(acc, CG + ((size_t)g * 8 + h) * 4096 + (size_t)v * 64 + 16 * g4);
            }
        }
    } else if (level == 1) {
        if (wave == 0 && blockIdx.x < 32) {
            const int h = blockIdx.x >> 2, s = blockIdx.x & 3, v = 16 * s + rho;
#pragma unroll
            for (int n = 0; n < 4; ++n) acc[n] = (f32x4){0.f, 0.f, 0.f, 0.f};
            chain16<true, true>(acc, MG + (size_t)h * 4096 + (size_t)(16 * g4) * 64 + 4 * rho, 32768, CG + (size_t)h * 4096 + (size_t)v * 64 + 16 * g4, 32768, P2_NG);
        }
    } else {
        const bool spread = (gridDim.x == 256);
        for (int it0 = spread ? (wave < 2 ? (int)blockIdx.x : P2_NG * 32) : gw; it0 < P2_NG * 8 * 4; it0 += spread ? P2_NG * 32 : ngw) {
            int it = it0;
            if (spread) { const int x = blockIdx.x & 7, j = blockIdx.x >> 3, idx = wave * 32 + j; it = ((idx >> 2) * 8 + x) * 4 + (idx & 3); }
            const int g = it >> 5, h = (it >> 2) & 7, s = it & 3, v = 16 * s + rho;
            const float* sg = CG + ((size_t)g * 8 + h) * 4096 + (size_t)v * 64 + 16 * g4;
            f32x4 q[4];
#pragma unroll
            for (int j = 0; j < 4; ++j) q[j] = *(const f32x4*)(sg + 4 * j);
#pragma unroll
            for (int n = 0; n < 4; ++n) acc[n] = (f32x4){q[0][n], q[1][n], q[2][n], q[3][n]};
            const float* Mb = MCM + ((size_t)(g * P2_GS) * 8 + h) * 4096 + (size_t)(16 * g4) * 64 + 4 * rho;
            float* Cb = MCC + ((size_t)(g * P2_GS) * 8 + h) * 4096 + (size_t)v * 64 + 16 * g4;
            chain16<true, true>(acc, Mb, 32768, Cb, 32768, P2_GS);
        }
    }
}

__device__ __forceinline__ void stage_postB(const Params& P, int e) {
    unsigned char* ws = P.ws;
    const bf16* PB = (const bf16*)(ws + OFF_PB); bf16* MIX = (bf16*)(ws + OFF_MIXE);
    int ch = threadIdx.x; asm volatile("" : "+v"(ch));
    const float* cw = P.in[I_BCONV] + (size_t)e * 3 * 512;
    const float w0 = cw[ch], w1 = cw[512 + ch], w2 = cw[1024 + ch];
    for (int tile = blockIdx.x; tile < T / 64; tile += gridDim.x) {
        const int t0 = tile * 64;
        float x0 = t0 >= 2 ? bf2f(PB[(size_t)(t0 - 2) * DINO + 512 + ch]) * bf2f(PB[(size_t)(t0 - 2) * DINO + 1024 + ch]) : 0.f;
        float x1 = t0 >= 1 ? bf2f(PB[(size_t)(t0 - 1) * DINO + 512 + ch]) * bf2f(PB[(size_t)(t0 - 1) * DINO + 1024 + ch]) : 0.f;
#pragma unroll 1
        for (int tb = t0; tb < t0 + 64; tb += 16) {
            bf16 rb[16], rc[16], rh[16];
#pragma unroll
            for (int i = 0; i < 16; ++i) { const bf16* row = PB + (size_t)(tb + i) * DINO; rb[i] = row[ch]; rc[i] = row[512 + ch]; rh[i] = row[1024 + ch]; }
            __builtin_amdgcn_sched_barrier(0);
            float bb[16], cc[16], hv[16];
#pragma unroll
            for (int i = 0; i < 16; ++i) { bb[i] = bf2f(rb[i]); cc[i] = bf2f(rc[i]); hv[i] = bf2f(rh[i]); }
#pragma unroll
            for (int i = 0; i < 16; ++i) { const float x2 = cc[i] * hv[i];
                MIX[(size_t)(tb + i) * D + 512 + ch] = (bf16)f2bf(bb[i] * (w0 * x0 + w1 * x1 + w2 * x2)); x0 = x1; x1 = x2; }
        }
    }
}

__device__ __forceinline__ void stage_lruE(const Params& P, int o) {
    unsigned char* ws = P.ws;
    const bf16* PO = (const bf16*)(ws + OFF_PO);
    bf16* UC = (bf16*)(ws + OFF_UC); bf16* PD = (bf16*)(ws + OFF_PD);
    int tid = threadIdx.x; asm volatile("" : "+v"(tid));
    const size_t gt = (size_t)blockIdx.x * NTHREADS + tid, ngt = (size_t)gridDim.x * NTHREADS;
    stage_images(P, 1, o);
    const float* cw = P.in[I_CCONVW] + (size_t)o * 4 * 512;
    for (size_t it = gt; it < (size_t)(T / 16) * 1024; it += ngt) {
        const int tile = (int)(it >> 10), c = (int)(it & 1023), t0 = tile * 16;
        if (c < 512) {
            const float cw0 = cw[c], cw1 = cw[512 + c], cw2 = cw[1024 + c], cw3 = cw[1536 + c], cb = P.in[I_CCONVB][o * 512 + c];
            float u[19]; bf16 raw[19];
#pragma unroll
            for (int i = 0; i < 19; ++i) { const int tg = t0 - 3 + i; raw[i] = PO[(size_t)(tg > 0 ? tg : 0) * DINO + 512 + c]; }
            __builtin_amdgcn_sched_barrier(0);
#pragma unroll
            for (int i = 0; i < 19; ++i) { const int tg = t0 - 3 + i; u[i] = tg >= 0 ? bf2f(raw[i]) : 0.f; }
#pragma unroll
            for (int i = 0; i < 16; ++i) UC[(size_t)(t0 + i) * 512 + c] = (bf16)f2bf(cw0 * u[i] + cw1 * u[i + 1] + cw2 * u[i + 2] + cw3 * u[i + 3] + cb);
        } else {
            const int cc = c - 512, gsel = cc >> 7, win = 2 << gsel;
            float xs[32]; bf16 raw[32];
#pragma unroll
            for (int i = 0; i < 32; ++i) { const int tg = t0 - 16 + i; raw[i] = PO[(size_t)(tg > 0 ? tg : 0) * DINO + 1024 + cc]; }
            __builtin_amdgcn_sched_barrier(0);
#pragma unroll
            for (int i = 0; i < 32; ++i) { const int tg = t0 - 16 + i; xs[i] = tg >= 0 ? bf2f(raw[i]) : 0.f; }
            float ps[32]; ps[0] = xs[0];
#pragma unroll
            for (int i = 1; i < 32; ++i) ps[i] = ps[i - 1] + xs[i];
#pragma unroll
            for (int i = 0; i < 16; ++i) {
                const int j = 16 + i, tg = t0 + i;
                const float s2 = ps[j] - ps[j - 2], s4 = ps[j] - ps[j - 4], s8 = ps[j] - ps[j - 8], s16 = ps[j] - ps[j - 16];
                const float sw = gsel == 0 ? s2 : gsel == 1 ? s4 : gsel == 2 ? s8 : s16;
                const int n = tg + 1 < win ? tg + 1 : win;
                PD[(size_t)tg * 512 + cc] = (bf16)f2bf(sw * frcp((float)n) - xs[j]);
            }
        }
    }
}
struct EpiGates {
    static constexpr bool PERM = true, AFTER_DRAIN = false;
    unsigned char* wsb; const float* ba; const float* bx; const float* lam;
    __device__ __forceinline__ void operator()(const f32x4 (&acc)[2][2][4][2], const pg8::Unit& u, int wr, int wc, int fr, int fq) const {
        const int row0 = u.pm * 256 + wr * 64 + fr, kind = u.pn >> 1, colb = (u.pn & 1) * 256 + wc * 32 + 8 * fq;
        float* OUT = (float*)(wsb + (kind == 0 ? OFF_LA : OFF_LBX));
        const float* bias = kind == 0 ? ba : bx;
#pragma unroll
        for (int bj = 0; bj < 2; ++bj) {
            const int col = colb + bj * 128;
            const f32x4 b0 = *(const f32x4*)(bias + col), b1 = *(const f32x4*)(bias + col + 4);
            f32x4 l0 = {1.f, 1.f, 1.f, 1.f}, l1 = {1.f, 1.f, 1.f, 1.f};
            if (kind == 0) {
                const f32x4 m0 = *(const f32x4*)(lam + col), m1 = *(const f32x4*)(lam + col + 4);
#pragma unroll
                for (int i = 0; i < 4; ++i) { l0[i] = -8.0f * (fmaxf(-m0[i], 0.f) + log1pf(expf(-fabsf(m0[i])))); l1[i] = -8.0f * (fmaxf(-m1[i], 0.f) + log1pf(expf(-fabsf(m1[i])))); }
            }
#pragma unroll
            for (int ai = 0; ai < 2; ++ai)
#pragma unroll
                for (int m = 0; m < 4; ++m) {
                    const size_t off = (size_t)(row0 + ai * 128 + m * 16) * 512 + col;
                    f32x4 v0 = acc[ai][bj][m][0] + b0, v1 = acc[ai][bj][m][1] + b1;
#pragma unroll
                    for (int i = 0; i < 4; ++i) { v0[i] = sigm(v0[i]) * l0[i]; v1[i] = sigm(v1[i]) * l1[i]; }
                    *(f32x4*)(OUT + off) = v0; *(f32x4*)(OUT + off + 4) = v1;
                }
        }
    }
};
struct EpiPool {
    static constexpr bool PERM = true, AFTER_DRAIN = false;
    bf16* MIX; const float* scale;
    __device__ __forceinline__ void operator()(const f32x4 (&acc)[2][2][4][2], const pg8::Unit& u, int wr, int wc, int fr, int fq) const {
        const int row0 = u.pm * 256 + wr * 64 + fr, colb = u.pn * 256 + wc * 32 + 8 * fq;
#pragma unroll
        for (int bj = 0; bj < 2; ++bj) {
            const int col = colb + bj * 128;
            const f32x4 s0 = *(const f32x4*)(scale + col), s1 = *(const f32x4*)(scale + col + 4);
#pragma unroll
            for (int ai = 0; ai < 2; ++ai)
#pragma unroll
                for (int m = 0; m < 4; ++m) {
                    const f32x4 v0 = acc[ai][bj][m][0] * s0, v1 = acc[ai][bj][m][1] * s1;
                    u32x4 w; w.x = pg8::cvt_pk_bf16(v0[0], v0[1]); w.y = pg8::cvt_pk_bf16(v0[2], v0[3]); w.z = pg8::cvt_pk_bf16(v1[0], v1[1]); w.w = pg8::cvt_pk_bf16(v1[2], v1[3]);
                    *(u32x4*)(MIX + (size_t)(row0 + ai * 128 + m * 16) * D + 512 + col) = w;
                }
        }
    }
};
__device__ __forceinline__ void stage_lruA(const Params& P) {
    unsigned char* ws = P.ws;
    float* LA = (float*)(ws + OFF_LA); float* LBX = (float*)(ws + OFF_LBX); float* CHA = (float*)(ws + OFF_CHA); float* CHB = (float*)(ws + OFF_CHB);
    const bf16* UC = (const bf16*)(ws + OFF_UC);
    int tid = threadIdx.x; asm volatile("" : "+v"(tid)); const int lane = tid & 63, wave = __builtin_amdgcn_readfirstlane(tid >> 6);
    const int gw = blockIdx.x * NWAVES + wave, ngw = gridDim.x * NWAVES;
    for (int it = gw; it < NCH * 8; it += ngw) {
        const int c = it >> 3, h = it & 7, ch = h * 64 + lane;
        float hh = 0.f, ap = 1.f;
#pragma unroll 1
        for (int tb = c * LCH; tb < (c + 1) * LCH; tb += 16) {
            float la[16], ig[16], uc[16];
#pragma unroll
            for (int i = 0; i < 16; ++i) { la[i] = LA[(size_t)(tb + i) * 512 + ch]; ig[i] = LBX[(size_t)(tb + i) * 512 + ch]; uc[i] = bf2f(UC[(size_t)(tb + i) * 512 + ch]); }
#pragma unroll
            for (int i = 0; i < 16; ++i) {
                const float a = __expf(la[i]), x2 = 2.f * la[i];
                const float em = x2 > -0.1f ? -x2 * (1.f + x2 * (0.5f + x2 * (0.16666667f + x2 * 0.041666668f))) : 1.f - __expf(x2);
                const float mult = (tb + i) == 0 ? 1.f : __builtin_amdgcn_sqrtf(em);
                const float bxv = mult * ig[i] * uc[i];
                hh = a * hh + bxv; ap *= a;
                LA[(size_t)(tb + i) * 512 + ch] = a; LBX[(size_t)(tb + i) * 512 + ch] = bxv;
            }
        }
        CHA[(size_t)c * 512 + ch] = ap; CHB[(size_t)c * 512 + ch] = hh;
    }
}
__device__ __forceinline__ void stage_lru2(const Params& P) {
    if (blockIdx.x >= 8) return;
    int tid = threadIdx.x; asm volatile("" : "+v"(tid)); if (tid >= 64) return;
    unsigned char* ws = P.ws;
    const float* CHA = (const float*)(ws + OFF_CHA); const float* CHB = (const float*)(ws + OFF_CHB); float* CAR = (float*)(ws + OFF_CAR);
    const int ch = blockIdx.x * 64 + tid;
    float hcar = 0.f;
#pragma unroll 8
    for (int c = 0; c < NCH; ++c) { CAR[(size_t)c * 512 + ch] = hcar; hcar = CHA[(size_t)c * 512 + ch] * hcar + CHB[(size_t)c * 512 + ch]; }
}
__device__ __forceinline__ float gelu_tanh(float x) { const float u = 0.7978845608028654f * (x + 0.044715f * x * x * x); return 0.5f * x * (1.f + tanh_fast(u)); }
__device__ __forceinline__ void stage_lru3(const Params& P) {
    unsigned char* ws = P.ws;
    const bf16* PO = (const bf16*)(ws + OFF_PO); bf16* MIX = (bf16*)(ws + OFF_MIXO);
    int tid = threadIdx.x; asm volatile("" : "+v"(tid)); const int lane = tid & 63, wave = __builtin_amdgcn_readfirstlane(tid >> 6);
    {
        const float* LA = (const float*)(ws + OFF_LA); const float* LBX = (const float*)(ws + OFF_LBX); const float* CAR = (const float*)(ws + OFF_CAR);
        const int gw = blockIdx.x * NWAVES + wave, ngw = gridDim.x * NWAVES;
        for (int it = gw; it < NCH * 8; it += ngw) {
            const int c = it >> 3, h = it & 7, ch = h * 64 + lane;
            const float* CHA = (const float*)(ws + OFF_CHA); const float* CHB = (const float*)(ws + OFF_CHB);
            float hh = 0.f;
#pragma unroll 1
            for (int cb = 0; cb < c; cb += 16) {
                float ca[16], cbv[16];
#pragma unroll
                for (int i = 0; i < 16; ++i) { const int cc = cb + i < c ? cb + i : c - 1; ca[i] = CHA[(size_t)cc * 512 + ch]; cbv[i] = CHB[(size_t)cc * 512 + ch]; }
#pragma unroll
                for (int i = 0; i < 16; ++i) if (cb + i < c) hh = ca[i] * hh + cbv[i];
            }
#pragma unroll 1
            for (int tb = c * LCH; tb < (c + 1) * LCH; tb += 16) {
                float a_[16], b_[16], g_[16];
#pragma unroll
                for (int i = 0; i < 16; ++i) { a_[i] = LA[(size_t)(tb + i) * 512 + ch]; b_[i] = LBX[(size_t)(tb + i) * 512 + ch]; g_[i] = bf2f(PO[(size_t)(tb + i) * DINO + ch]); }
#pragma unroll
                for (int i = 0; i < 16; ++i) { hh = a_[i] * hh + b_[i]; MIX[(size_t)(tb + i) * D + ch] = (bf16)f2bf(gelu_tanh(g_[i]) * hh); }
            }
        }
    }
}

constexpr int OPS_PER_LAYER = 19;
constexpr int N_PHASES = DEPTH * OPS_PER_LAYER + 1;
#ifndef MK_PER_PHASE_LAUNCH
#define MK_PER_PHASE_LAUNCH 0
#endif
__host__ __device__ inline bool phase_is_nop(int ph) {
    if (ph >= DEPTH * OPS_PER_LAYER) return false;
    const int layer = ph / OPS_PER_LAYER, op = ph % OPS_PER_LAYER;
    return ((layer & 1) && ((op >= 10 && op <= 14) || op == 8)) || (layer == 0 && op == 7);
}

__device__ __forceinline__ void ffn_weights(const Params& P, int layer, int which, LAS float* scr, int gw, int ngw, int lane) {
    const size_t fo = ((size_t)layer * 2 + which) * (size_t)D * FF;
    bf16* Wgu = (bf16*)(P.ws + OFF_W); bf16* Wdt = (bf16*)(P.ws + OFF_WB);
    conv_matrix(P.in[I_WG] + fo, D, FF, Wgu, 1, scr, gw, ngw, lane);
    conv_matrix(P.in[I_WU] + fo, D, FF, Wgu, 2, scr, gw, ngw, lane);
    conv_matrix(P.in[I_WD] + fo, FF, D, Wdt, 0, scr, gw, ngw, lane);
}

#define XB_TMO      128
#define XB_XCNT(j)  (256  + 64 * (j))
#define XB_XSUB(j)  (1280 + 64 * (j))
#define XB_XGEN(j)  (2304 + 64 * (j))
#define XB_TOP      3328
#define XB_TOPGEN   3392
#define XCD_BAR_WORDS 3456
#define XB_SPIN_CAP (1u << 18)

__device__ __forceinline__ unsigned xb_ld(unsigned* p)              { return __hip_atomic_load(p, __ATOMIC_RELAXED, __HIP_MEMORY_SCOPE_AGENT); }
__device__ __forceinline__ unsigned xb_add(unsigned* p, unsigned v) { return __hip_atomic_fetch_add(p, v, __ATOMIC_RELAXED, __HIP_MEMORY_SCOPE_AGENT); }
__device__ __forceinline__ unsigned xb_xcc_id() { return (unsigned)__builtin_amdgcn_s_getreg((3 << 11) | 20) & 0xFu; }
#define XB_SPIN(cond, bar) do { unsigned _sp = 0; while (cond) { __builtin_amdgcn_s_sleep(1); \
    if ((++_sp & 255u) == 0u) { if (xb_ld(&(bar)[XB_TMO])) break; if (_sp > XB_SPIN_CAP) { atomicAdd(&(bar)[XB_TMO], 1u); break; } } } } while (0)

struct XcdBarrier {
    unsigned* bar; unsigned x;
    volatile LAS unsigned* st;
};

__device__ __forceinline__ XcdBarrier xcd_barrier_post(unsigned* bar, volatile LAS unsigned* st) {
    XcdBarrier b; b.bar = bar; b.x = xb_xcc_id(); b.st = st;
    if (threadIdx.x == 0) (void)xb_add(&bar[XB_XCNT(b.x)], 1u);
    return b;
}
__device__ __forceinline__ void xcd_barrier_complete(unsigned* bar, unsigned x, unsigned& nloc, unsigned& nx) {
    const unsigned G = gridDim.x * gridDim.y * gridDim.z;
    unsigned sum, cnt, mine, sp = 0u;
    for (;;) {
        sum = 0u; cnt = 0u; mine = 0u;
#pragma unroll
        for (unsigned j = 0; j < 16; ++j) { const unsigned c = xb_ld(&bar[XB_XCNT(j)]); sum += c; cnt += (c > 0u) ? 1u : 0u; mine = (j == x) ? c : mine; }
        if (sum == G) break;
        __builtin_amdgcn_s_sleep(1);
        if ((++sp & 255u) == 0u) { if (xb_ld(&bar[XB_TMO])) break; if (sp > XB_SPIN_CAP) { atomicAdd(&bar[XB_TMO], 1u); break; } }
    }
    nloc = mine > 0u ? mine : 1u; nx = cnt > 0u ? cnt : 1u;
}

__device__ __forceinline__ void xcd_barrier(const XcdBarrier& b) {
    asm volatile("s_waitcnt vmcnt(0)" ::: "memory");
    __syncthreads();
    if (threadIdx.x == 0) {
        unsigned* bar = b.bar;
        __builtin_amdgcn_s_waitcnt(0);
        unsigned nloc = b.st[0], nx = b.st[1];
        if (nloc == 0u) { xcd_barrier_complete(bar, b.x, nloc, nx); b.st[0] = nloc; b.st[1] = nx; }
        const unsigned old = xb_add(&bar[XB_XSUB(b.x)], 1u);
        const unsigned gen = old / nloc;
        if (old + 1u == (gen + 1u) * nloc) {
            __builtin_amdgcn_fence(__ATOMIC_RELEASE, "agent");
            asm volatile("s_waitcnt vmcnt(0)" ::: "memory");
            const unsigned og = xb_add(&bar[XB_TOP], 1u);
            const unsigned tg = og / nx;
            if (og + 1u == (tg + 1u) * nx) xb_add(&bar[XB_TOPGEN], 1u);
            else XB_SPIN(xb_ld(&bar[XB_TOPGEN]) == tg, bar);
            __builtin_amdgcn_fence(__ATOMIC_ACQUIRE, "agent");
            xb_add(&bar[XB_XGEN(b.x)], 1u);
            asm volatile("s_waitcnt vmcnt(0)" ::: "memory");
        } else {
            XB_SPIN(xb_ld(&bar[XB_XGEN(b.x)]) == gen, bar);
            __builtin_amdgcn_fence(__ATOMIC_ACQUIRE, "agent");
            asm volatile("s_waitcnt vmcnt(0)" ::: "memory");
        }
    }
    __syncthreads();
}


static_assert(XCD_BAR_WORDS * 4 <= SZ_CTL, "ctl");
#ifndef PROBE_MASK
#define PROBE_MASK 0
#endif
#ifndef PROBE_PAR
#define PROBE_PAR -1
#endif
#ifndef PROBE_SYNCS
#define PROBE_SYNCS 0
#endif
__device__ __forceinline__ void run_phase(const Params& P, int ph, LAS unsigned char* lds, bool junk) {
    unsigned char* ws = P.ws;
    int tid = threadIdx.x; asm volatile("" : "+v"(tid));
    const int lane = tid & 63, wave = __builtin_amdgcn_readfirstlane(tid >> 6);
    const int gw = blockIdx.x * NWAVES + wave, ngw = gridDim.x * NWAVES;
    LAS float* scr = (LAS float*)(lds + wave * 16384);
    float* X = (float*)(ws + OFF_X); bf16* H = (bf16*)(ws + OFF_H); bf16* ACT = (bf16*)(ws + OFF_ACT);
    bf16* W0 = (bf16*)(ws + OFF_W); bf16* W1 = (bf16*)(ws + OFF_WB);
    if (ph == DEPTH * OPS_PER_LAYER) { rmsnorm_rows(X, P.in[I_FINALG], nullptr, P.out, gw, ngw, lane); return; }
    const int layer = ph / OPS_PER_LAYER, op = ph % OPS_PER_LAYER, odd = layer & 1, idx = layer >> 1;
    const float* Xin = (layer == 0) ? P.in[I_X] : X;
    switch (op) {
    case 0: ffn_weights(P, layer, 0, scr, gw, ngw, lane); rmsnorm_rows(Xin, P.in[I_NORMG] + ((size_t)layer * 3 + 0) * D, H, nullptr, gw, ngw, lane); break;
    case 1: case 17: run_gemm(lds, H, W0, T, 2 * FF, D, EpiSwiglu{ACT}); break;
    case 2: run_gemm(lds, ACT, W1, T, D, FF, EpiResid{Xin, junk ? (float*)(ws + OFF_U + 100000000) : X, 0.5f}); break;
    case 18: run_gemm(lds, ACT, W1, T, D, FF, EpiResid{X, junk ? (float*)(ws + OFF_U + 100000000) : X, 0.5f}); break;
    case 3:
        if (!odd) { conv_matrix(P.in[I_EWIN] + (size_t)idx * D * DINE, D, DINE, W0, 0, scr, gw, ngw, lane);
                    conv_matrix(P.in[I_EWOUT] + (size_t)idx * D * D, D, D, W1, 0, scr, gw, ngw, lane); }
        else      { conv_matrix(P.in[I_OWIN] + (size_t)idx * D * DINO, D, DINO, W0, 0, scr, gw, ngw, lane);
                    conv_matrix(P.in[I_OWOUT] + (size_t)idx * D * D, D, D, W1, 0, scr, gw, ngw, lane); }
        rmsnorm_rows(X, P.in[I_NORMG] + ((size_t)layer * 3 + 1) * D, H, nullptr, gw, ngw, lane); break;
    case 4:
        if (!odd) run_gemm(lds, H, W0, T, DINA, D, EpiStoreBf16{(bf16*)(ws + OFF_PA), DINA});
        else      run_gemm(lds, H, W0, T, DINO, D, EpiStoreBf16{(bf16*)(ws + OFF_PO), DINO});
        break;
    case 5: if (!odd) stage_prepE(P, idx); else stage_lruE(P, idx); break;
    case 6:
        if (!odd) {
            run_gemm(lds, (const bf16*)(ws + OFF_LIN), (const bf16*)(ws + OFF_WCAT), T, 1536, 256,
                     EpiLora{ws, P.in[I_AW0] + idx * 512, P.in[I_AA0] + idx * 512});
            if (idx > 0) run_gemm(lds, (const bf16*)(ws + OFF_V16), (const bf16*)(ws + OFF_WVDN), T, 256, 512, EpiStoreBf16{(bf16*)(ws + OFF_LOW), 256});
        } else {
            run_gemm(lds, (const bf16*)(ws + OFF_UC), (const bf16*)(ws + OFF_WG), T, 1024, 512, EpiGates{ws, P.in[I_CBA] + idx * 512, P.in[I_CBX] + idx * 512, P.in[I_CLAM] + idx * 512});
            run_gemm(lds, (const bf16*)(ws + OFF_PD), (const bf16*)(ws + OFF_WP), T, 512, 512, EpiPool{(bf16*)(ws + OFF_MIXO), P.in[I_DSCALE] + idx * 512});
        }
        break;
    case 7:
        if (!odd) run_gemm(lds, (const bf16*)(ws + OFF_LOW), (const bf16*)(ws + OFF_WVUP), T, 512, 256, EpiVres{(bf16*)(ws + OFF_V16), (const bf16*)(ws + OFF_VF), P.in[I_AV0] + (idx - 1) * 512});
        else stage_lruA(P);
        break;
    case 8: if (!odd) stage_rwkv_scan<0>(P, idx, lds); break;
    case 9: if (!odd) stage_rwkv_pass2(P, 0); else stage_lru3(P); break;
    case 10: stage_rwkv_pass2(P, 1); break;
    case 11: stage_rwkv_pass2(P, 2); break;
    case 12: stage_rwkv_scan<1>(P, idx, lds); break;
    case 13: run_gemm(lds, H, W0 + (size_t)DINA * D, T, DINO, D, EpiStoreBf16{(bf16*)(ws + OFF_PB), DINO}); break;
    case 14: stage_postB(P, idx); break;
    case 15: run_gemm(lds, (const bf16*)(ws + (odd ? OFF_MIXO : OFF_MIXE)), W1, T, D, D, EpiResid{X, junk ? (float*)(ws + OFF_U) : X, 1.0f}); break;
    case 16: ffn_weights(P, layer, 1, scr, gw, ngw, lane); rmsnorm_rows(X, P.in[I_NORMG] + ((size_t)layer * 3 + 2) * D, H, nullptr, gw, ngw, lane); break;
    default: break;
    }
}

__global__ void __launch_bounds__(NTHREADS, 2) mega_fwd(Params P) {
    extern __shared__ __attribute__((aligned(16))) unsigned char lds_raw[];
    LAS unsigned char* lds = (LAS unsigned char*)lds_raw;
    cg::grid_group grid = cg::this_grid();
    bool first = true;
    const int ph_lo = P.ph_lo, ph_hi = P.ph_hi;
    if (ph_lo < 0) grid.sync();
    volatile LAS unsigned* bst = (volatile LAS unsigned*)(lds + 131072 + 64);
    if (threadIdx.x < 2) bst[threadIdx.x] = 0u;
    __syncthreads();
    (void)xcd_barrier_post((unsigned*)(P.ws + OFF_CTL), bst);
#define GRID_BAR() do { const __attribute__((address_space(4))) Params* Pb = (const __attribute__((address_space(4))) Params*)__builtin_amdgcn_kernarg_segment_ptr(); asm volatile("" : "+s"(Pb)); \
        XcdBarrier bar_; bar_.bar = (unsigned*)(Pb->ws + OFF_CTL); bar_.x = xb_xcc_id(); bar_.st = (volatile LAS unsigned*)(lds + 131072 + 64); xcd_barrier(bar_); } while (0)
    for (int i = 0; i < PROBE_SYNCS; ++i) GRID_BAR();
    for (int ph = ph_lo; ph < ph_hi; ++ph) {
        if (phase_is_nop(ph)) continue;
        int nrep = 1;
        if (PROBE_MASK != 0 && ph < DEPTH * OPS_PER_LAYER) {
            const int layer = ph / OPS_PER_LAYER, op = ph % OPS_PER_LAYER;
            if (((PROBE_MASK >> op) & 1) && (PROBE_PAR < 0 || (layer & 1) == PROBE_PAR) && !((op == 7 || op == 10 || op == 11) && !(layer & 1)) && !((op == 7) && (layer & 1))) nrep = 2;
        }
        for (int rep = 0; rep < nrep; ++rep) {
            if (!first) GRID_BAR();
            first = false;
            const __attribute__((address_space(4))) Params* Pk = (const __attribute__((address_space(4))) Params*)__builtin_amdgcn_kernarg_segment_ptr();
            asm volatile("" : "+s"(Pk));
            run_phase(*(const Params*)Pk, ph, lds, rep > 0);
            __syncthreads();
        }
    }
}

extern "C" void kernel_launch(void* const* d_in, const int* in_sizes, int n_in, void* d_out, int out_size, void* d_ws, size_t ws_size, hipStream_t stream) {
    static int grid = 0;
    if (grid == 0) {
        if (n_in != N_IN || out_size != T * D || ws_size < WS_END) { fprintf(stderr, "kernel_launch: unexpected shapes (n_in %d, out %d, ws %zu, need %zu)\n", n_in, out_size, ws_size, (size_t)WS_END); grid = -1; return; }
        int dev = 0, cus = 0, per_cu = 0;
        hipGetDevice(&dev); hipDeviceGetAttribute(&cus, hipDeviceAttributeMultiprocessorCount, dev);
        if (hipFuncSetAttribute((const void*)mega_fwd, hipFuncAttributeMaxDynamicSharedMemorySize, LDS_BYTES) != hipSuccess) { fprintf(stderr, "kernel_launch: hipFuncSetAttribute failed\n"); grid = -1; return; }
        hipOccupancyMaxActiveBlocksPerMultiprocessor(&per_cu, (const void*)mega_fwd, NTHREADS, LDS_BYTES);
        if (per_cu < 1) per_cu = 1;
        grid = cus * 1;
    }
    if (grid <= 0) return;
    Params P{};
    for (int i = 0; i < N_IN; ++i) P.in[i] = (const float*)d_in[i];
    P.out = (float*)d_out; P.ws = (unsigned char*)d_ws;
#if MK_PER_PHASE_LAUNCH
    for (int ph = 0; ph < N_PHASES; ++ph) {
        if (phase_is_nop(ph)) continue;
        P.ph_lo = ph; P.ph_hi = ph + 1;
        void* args[] = {&P};
        hipError_t e = hipLaunchCooperativeKernel((const void*)mega_fwd, dim3(grid), dim3(NTHREADS), args, LDS_BYTES, stream);
        if (e != hipSuccess) { fprintf(stderr, "launch %d failed: %s\n", ph, hipGetErrorString(e)); break; }
    }
#else
    P.ph_lo = 0; P.ph_hi = N_PHASES;
    if (hipMemsetAsync((char*)d_ws + OFF_CTL, 0, SZ_CTL, stream) != hipSuccess) { fprintf(stderr, "memset failed\n"); return; }
    void* args[] = {&P};
    hipError_t e = hipLaunchCooperativeKernel((const void*)mega_fwd, dim3(grid), dim3(NTHREADS), args, LDS_BYTES, stream);
    if (e != hipSuccess) fprintf(stderr, "cooperative launch failed: %s (grid %d)\n", hipGetErrorString(e), grid);
#endif
}
```
